# Optimizing an MI355X kernel written in HIP

```python
import jax, jax.numpy as jnp
from jax import lax
import numpy as np

D_MODEL = 1024
BATCH = 32
SEQ = 2048
DEPTH = 1

D_MIX = D_MODEL
SG_WIDTH = D_MIX // 2
SG_GROUPS = 8
SG_GROUP_DIM = SG_WIDTH // SG_GROUPS
SG_CHUNK = 128
DN_WIDTH = D_MIX - SG_WIDTH
DN_HEAD_DIM = 128
DN_HEADS = DN_WIDTH // DN_HEAD_DIM
DN_CHUNK = 64
CONV_K = 4
D_FF = 2816
EPS = 1e-6
IN_COLS = 2 * SG_WIDTH + 4 * DN_WIDTH + 2 * DN_HEADS

kernel_name = "hybrid_gmlp_gated_deltanet_macaron"


def rmsnorm(x, g):
    xf = x.astype(jnp.float32)
    y = xf * lax.rsqrt(jnp.mean(xf * xf, axis=-1, keepdims=True) + EPS)
    return (y * g.astype(jnp.float32)).astype(x.dtype)


def layernorm(x, g, b):
    xf = x.astype(jnp.float32)
    mu = jnp.mean(xf, axis=-1, keepdims=True)
    var = jnp.mean(jnp.square(xf - mu), axis=-1, keepdims=True)
    y = (xf - mu) * lax.rsqrt(var + EPS)
    return (y * g.astype(jnp.float32) + b.astype(jnp.float32)).astype(x.dtype)


def l2norm(x):
    return x * lax.rsqrt(jnp.sum(x * x, axis=-1, keepdims=True) + EPS)


def swiglu(h, w_gate, w_up, w_down):
    return (jax.nn.silu(h @ w_gate) * (h @ w_up)) @ w_down


def causal_dwconv(x, w):
    k_taps = w.shape[0]
    t_len = x.shape[1]
    xp = jnp.pad(x, ((0, 0), (k_taps - 1, 0), (0, 0)))
    y = xp[:, 0:t_len] * w[0]
    for j in range(1, k_taps):
        y = y + xp[:, j:j + t_len] * w[j]
    return y


def chunked_spatial_gating(u, v, ln_g, ln_b, w_s, b_s):
    bsz, t_len, _ = v.shape
    n_chunks = t_len // SG_CHUNK
    v = layernorm(v, ln_g, ln_b).reshape(bsz, n_chunks, SG_CHUNK, SG_GROUPS, SG_GROUP_DIM)
    pos = jnp.arange(SG_CHUNK)
    causal = pos[:, None] >= pos[None, :]
    w_causal = jnp.where(causal, w_s, jnp.zeros((), w_s.dtype))
    vs = jnp.einsum('gts,bnsgc->bntgc', w_causal, v) + b_s.T[:, :, None]
    return u * vs.reshape(bsz, t_len, SG_WIDTH)


def gated_delta_rule(q, k, v, g, beta):
    bsz, t_len, n_heads, dk = q.shape
    dv = v.shape[-1]
    c = DN_CHUNK
    n_chunks = t_len // c

    def chunks(a):
        return a.reshape(bsz, n_chunks, c, n_heads, a.shape[-1]).transpose(1, 0, 3, 2, 4)

    q = chunks(q) * (dk ** -0.5)
    k = chunks(k)
    v = chunks(v)
    g = chunks(g[..., None])[..., 0]
    beta = chunks(beta[..., None])[..., 0]
    gc = jnp.cumsum(g, axis=-1)
    pos = jnp.arange(c)
    incl = pos[:, None] >= pos[None, :]
    strict = pos[:, None] > pos[None, :]
    decay = jnp.exp(jnp.where(incl, gc[..., :, None] - gc[..., None, :], -jnp.inf))
    k_beta = k * beta[..., None]
    v_beta = v * beta[..., None]
    l_mat = jnp.where(strict, jnp.einsum('nbhcd,nbhsd->nbhcs', k_beta, k) * decay, 0.0)
    rhs = jnp.concatenate([v_beta, k_beta * jnp.exp(gc)[..., None]], axis=-1)
    sol = lax.linalg.triangular_solve(l_mat, rhs, left_side=True, lower=True, unit_diagonal=True)
    u_wy, w_wy = sol[..., :dv], sol[..., dv:]
    qk = jnp.einsum('nbhcd,nbhsd->nbhcs', q, k) * decay
    q_dec = q * jnp.exp(gc)[..., None]
    k_dec = k * jnp.exp(gc[..., -1:] - gc)[..., None]
    g_last = jnp.exp(gc[..., -1])

    def step(state, xs):
        q_n, k_n, u_n, w_n, qk_n, gl_n = xs
        v_new = u_n - jnp.einsum('bhcd,bhde->bhce', w_n, state)
        o_n = jnp.einsum('bhcd,bhde->bhce', q_n, state) + jnp.einsum('bhcs,bhse->bhce', qk_n, v_new)
        state = state * gl_n[..., None, None] + jnp.einsum('bhcd,bhce->bhde', k_n, v_new)
        return state, o_n

    s0 = jnp.zeros((bsz, n_heads, dk, dv), jnp.float32)
    _, o = lax.scan(step, s0, (q_dec, k_dec, u_wy, w_wy, qk, g_last))
    return o.transpose(1, 0, 3, 2, 4).reshape(bsz, t_len, n_heads, dv)


def hybrid_mixer(h, w_in, conv_w, a_log, dt_bias, dn_norm, sg_ln_g, sg_ln_b, sg_w, sg_b, w_out):
    bsz, t_len, _ = h.shape
    proj = h @ w_in
    o1 = SG_WIDTH
    o2 = 2 * SG_WIDTH
    o3 = o2 + 3 * DN_WIDTH
    o4 = o3 + DN_WIDTH
    o5 = o4 + DN_HEADS
    sg_u, sg_v, dn_qkv, dn_z, dn_b, dn_a = jnp.split(proj, [o1, o2, o3, o4, o5], axis=-1)

    sg_out = chunked_spatial_gating(jax.nn.gelu(sg_u), jax.nn.gelu(sg_v), sg_ln_g, sg_ln_b, sg_w, sg_b)

    qkv = jax.nn.silu(causal_dwconv(dn_qkv, conv_w)).astype(jnp.float32)
    q, k, v = jnp.split(qkv, 3, axis=-1)
    q = l2norm(q.reshape(bsz, t_len, DN_HEADS, DN_HEAD_DIM))
    k = l2norm(k.reshape(bsz, t_len, DN_HEADS, DN_HEAD_DIM))
    v = v.reshape(bsz, t_len, DN_HEADS, DN_HEAD_DIM)
    beta = jax.nn.sigmoid(dn_b.astype(jnp.float32))
    g = -jnp.exp(a_log.astype(jnp.float32)) * jax.nn.softplus(dn_a.astype(jnp.float32) + dt_bias.astype(jnp.float32))
    o = gated_delta_rule(q, k, v, g, beta)
    o = o * lax.rsqrt(jnp.mean(o * o, axis=-1, keepdims=True) + EPS) * dn_norm.astype(jnp.float32)
    z = dn_z.reshape(bsz, t_len, DN_HEADS, DN_HEAD_DIM).astype(jnp.float32)
    dn_out = (o * jax.nn.silu(z)).reshape(bsz, t_len, DN_WIDTH).astype(h.dtype)

    return jnp.concatenate([sg_out, dn_out], axis=-1) @ w_out


def setup_inputs(seed: int = 0) -> dict:
    key = jax.random.key(seed)
    ks = jax.random.split(key, 24)
    f32 = jnp.float32

    def nrm(k, shape, scale):
        return jax.random.normal(k, shape, f32) * scale

    def gain(k, shape):
        return 1.0 + 0.02 * jax.random.normal(k, shape, f32)

    dt = jnp.exp(jax.random.uniform(ks[8], (DEPTH, DN_HEADS), f32, np.log(0.001), np.log(0.1)))
    return {
        "x": jax.random.normal(ks[0], (BATCH, SEQ, D_MODEL), f32),
        "ffn1_norm": gain(ks[1], (DEPTH, D_MODEL)),
        "ffn1_w_gate": nrm(ks[2], (DEPTH, D_MODEL, D_FF), D_MODEL ** -0.5),
        "ffn1_w_up": nrm(ks[3], (DEPTH, D_MODEL, D_FF), D_MODEL ** -0.5),
        "ffn1_w_down": nrm(ks[4], (DEPTH, D_FF, D_MODEL), D_FF ** -0.5),
        "mix_norm": gain(ks[5], (DEPTH, D_MODEL)),
        "w_in": nrm(ks[6], (DEPTH, D_MODEL, IN_COLS), D_MODEL ** -0.5),
        "conv_w": nrm(ks[7], (DEPTH, CONV_K, 3 * DN_WIDTH), CONV_K ** -0.5),
        "a_log": jnp.log(jax.random.uniform(ks[9], (DEPTH, DN_HEADS), f32, 1.0, 16.0)),
        "dt_bias": dt + jnp.log(-jnp.expm1(-dt)),
        "dn_norm": gain(ks[10], (DEPTH, DN_HEAD_DIM)),
        "sg_ln_g": gain(ks[11], (DEPTH, SG_WIDTH)),
        "sg_ln_b": nrm(ks[12], (DEPTH, SG_WIDTH), 0.02),
        "sg_w": nrm(ks[13], (DEPTH, SG_GROUPS, SG_CHUNK, SG_CHUNK), SG_CHUNK ** -0.5),
        "sg_b": gain(ks[14], (DEPTH, SG_GROUPS, SG_CHUNK)),
        "w_out": nrm(ks[15], (DEPTH, D_MIX, D_MODEL), D_MIX ** -0.5),
        "ffn2_norm": gain(ks[16], (DEPTH, D_MODEL)),
        "ffn2_w_gate": nrm(ks[17], (DEPTH, D_MODEL, D_FF), D_MODEL ** -0.5),
        "ffn2_w_up": nrm(ks[18], (DEPTH, D_MODEL, D_FF), D_MODEL ** -0.5),
        "ffn2_w_down": nrm(ks[19], (DEPTH, D_FF, D_MODEL), D_FF ** -0.5),
        "final_norm": gain(ks[20], (D_MODEL,)),
    }


def reference(x, ffn1_norm, ffn1_w_gate, ffn1_w_up, ffn1_w_down, mix_norm, w_in, conv_w, a_log,
              dt_bias, dn_norm, sg_ln_g, sg_ln_b, sg_w, sg_b, w_out, ffn2_norm, ffn2_w_gate,
              ffn2_w_up, ffn2_w_down, final_norm):
    for l in range(DEPTH):
        h = rmsnorm(x, ffn1_norm[l])
        x = x + 0.5 * swiglu(h, ffn1_w_gate[l], ffn1_w_up[l], ffn1_w_down[l])
        h = rmsnorm(x, mix_norm[l])
        x = x + hybrid_mixer(h, w_in[l], conv_w[l], a_log[l], dt_bias[l], dn_norm[l],
                             sg_ln_g[l], sg_ln_b[l], sg_w[l], sg_b[l], w_out[l])
        h = rmsnorm(x, ffn2_norm[l])
        x = x + 0.5 * swiglu(h, ffn2_w_gate[l], ffn2_w_up[l], ffn2_w_down[l])
    return rmsnorm(x, final_norm)
```

```cpp
#include <hip/hip_runtime.h>
#include <hip/hip_cooperative_groups.h>
#include <cstdio>
namespace cg = cooperative_groups;
namespace pg8 {
#define PG8_LAS __attribute__((address_space(3)))
typedef unsigned short bf16_t;
typedef short bf16x8 __attribute__((ext_vector_type(8)));
typedef float f32x4 __attribute__((ext_vector_type(4)));
typedef unsigned u32x4 __attribute__((ext_vector_type(4)));
constexpr int BM = 256, BK = 64, HALF = 128, HTB = HALF * BK * 2  , STAGE_BYTES = 8 * HTB, NXCD = 8, WGM = 8;

__host__ __device__ __forceinline__ int lds_byte(int r, int c) { const int st = (r >> 4) * 2 + (c >> 5), rr = r & 15, cc = c & 31, ob = rr * 64 + cc * 2; return st * 1024 + (ob ^ (((ob >> 9) & 1) << 5)); }
__host__ __device__ __forceinline__ void stage_rc(int b, int& R, int& C) { const int st = b / 1024, sb = b % 1024, swz = sb ^ (((sb >> 9) & 1) << 5); R = (st >> 1) * 16 + swz / 64; C = (st & 1) * 32 + (swz % 64) / 2; }
__host__ __device__ __forceinline__ int perm32(int rho) { const int n = rho >> 4, i = rho & 15; return 8 * (i >> 2) + 4 * n + (i & 3); }

struct Unit { int pm, pn; };
struct Gemm { const bf16_t* A; const bf16_t* Bt; int M, N, K; };

struct StaticOrder {
    int nM, nN, nwg, G, c;
    __host__ __device__ void init(int M, int N, int G_, int c_) { nM = M / BM; nN = N / BM; nwg = nM * nN; G = G_; c = c_; }
    __host__ __device__ bool next(int i, Unit& u) const {
        const long L = (long)i * G + c; if (L >= nwg) return false;
        int wgid = (int)L; { const int q = nwg / NXCD, r = nwg % NXCD, xcd = wgid % NXCD, off = wgid / NXCD; wgid = (xcd < r ? xcd * (q + 1) : r * (q + 1) + (xcd - r) * q) + off; }
        const int nig = WGM * nN, gid = wgid / nig, fm = gid * WGM, gsz = (nM - fm) < WGM ? (nM - fm) : WGM;
        u.pm = fm + ((wgid % nig) % gsz); u.pn = (wgid % nig) / gsz; return true;
    }
    __device__ __forceinline__ void a_ready(const Unit&) const {}
    __device__ __forceinline__ void done(const Unit&) const {}
};
__device__ __forceinline__ unsigned cvt_pk_bf16(float lo, float hi) { unsigned r; asm volatile("v_cvt_pk_bf16_f32 %0, %1, %2" : "=v"(r) : "v"(lo), "v"(hi)); return r; }
template <class Epi, class Sched, bool STAMP = false>
__device__ __forceinline__ void gemm_phase(PG8_LAS unsigned char* lds, const Gemm g, const Sched& S, const Epi& E, unsigned long long* stamps) {
    const int tid = threadIdx.x, wid = __builtin_amdgcn_readfirstlane(tid >> 6), lane = tid & 63, wr = wid >> 2, wc = wid & 3, fr = lane & 15, fq = lane >> 4;
    const int K = g.K, nt = K / BK;
    int ts_lo = 0, ts_hi = 0, nts = 0; const unsigned long long rt_entry = STAMP ? (unsigned long long)wall_clock64() : 0ull;
#define PG8_STAMP() do { if (STAMP && wid == 0 && nts < 64) { const unsigned long long _c = (unsigned long long)clock64(); \
        ts_lo = (lane == nts) ? (int)(unsigned)_c : ts_lo; ts_hi = (lane == nts) ? (int)(unsigned)(_c >> 32) : ts_hi; ++nts; } } while (0)
    PG8_STAMP();
    unsigned voffA[2], voffB[2];
#pragma unroll
    for (int i = 0; i < 2; ++i) { int R, C; stage_rc(tid * 16 + i * 8192, R, C); const int Rb = Epi::PERM ? ((R & ~31) + perm32(R & 31)) : R;
        voffA[i] = (unsigned)(R * K + C) * 2u; voffB[i] = (unsigned)(Rb * K + C) * 2u; }
    const size_t kstep = (size_t)(BK * 2);
    const size_t hstep = (size_t)HALF * K * 2;
    const size_t tstep = 2 * hstep;
    const unsigned ldsw = (unsigned)wid * 1024u;
    const int aoff = lds_byte(wr * 64 + fr, fq * 8), boff = lds_byte(wc * 32 + fr, fq * 8);
#define PG8_SA(b, h) (((b) * 2 + (h)) * HTB)
#define PG8_SB(b, h) ((4 + (b) * 2 + (h)) * HTB)
#define PG8_STAGE(bufoff, gbase, voff) do { _Pragma("unroll") for (int _i = 0; _i < 2; ++_i) \
        __builtin_amdgcn_global_load_lds((const unsigned*)((const char*)(gbase) + (voff)[_i]), (PG8_LAS unsigned*)(lds + (bufoff) + ldsw + _i * 8192), 16, 0, 0); } while (0)
#define PG8_LDA(dst, b, h) do { _Pragma("unroll") for (int m = 0; m < 4; ++m) _Pragma("unroll") for (int k = 0; k < 2; ++k) dst[m][k] = *(const PG8_LAS bf16x8*)(lds + PG8_SA(b, h) + aoff + m * 2048 + k * 1024); } while (0)
#define PG8_LDB(dst, b, h) do { _Pragma("unroll") for (int n = 0; n < 2; ++n) _Pragma("unroll") for (int k = 0; k < 2; ++k) dst[n][k] = *(const PG8_LAS bf16x8*)(lds + PG8_SB(b, h) + boff + n * 2048 + k * 1024); } while (0)
#define PG8_MMA(ai, bj, At, Bt) do { __builtin_amdgcn_s_setprio(1); _Pragma("unroll") for (int m = 0; m < 4; ++m) _Pragma("unroll") for (int n = 0; n < 2; ++n) _Pragma("unroll") for (int k = 0; k < 2; ++k) \
        acc[ai][bj][m][n] = __builtin_amdgcn_mfma_f32_16x16x32_bf16(Bt[n][k], At[m][k], acc[ai][bj][m][n], 0, 0, 0); __builtin_amdgcn_s_setprio(0); } while (0)
#define PG8_WAIT_V(n) asm volatile("s_waitcnt vmcnt(" #n ")" ::: "memory")
#define PG8_WAIT_L(n) asm volatile("s_waitcnt lgkmcnt(" #n ")" ::: "memory")
#define PG8_BAR __builtin_amdgcn_s_barrier()
#define PG8_SCHED __builtin_amdgcn_sched_barrier(0)
    Unit cur, nxt; int ui = 0;
    if (!S.next(0, cur)) return;
    f32x4 acc[2][2][4][2];
#pragma unroll
    for (int a = 0; a < 2; ++a)
#pragma unroll
        for (int b = 0; b < 2; ++b)
#pragma unroll
            for (int m = 0; m < 4; ++m)
#pragma unroll
                for (int n = 0; n < 2; ++n) acc[a][b][m][n] = (f32x4){0.f, 0.f, 0.f, 0.f};
    bf16x8 At[4][2], B0[2][2], B1[2][2];
    const char* cA = (const char*)g.A + (size_t)cur.pm * tstep; const char* cB = (const char*)g.Bt + (size_t)cur.pn * tstep;
    S.a_ready(cur);
    PG8_STAGE(PG8_SB(0, 0), cB, voffB); PG8_STAGE(PG8_SA(0, 0), cA, voffA); PG8_STAGE(PG8_SB(0, 1), cB + hstep, voffB); PG8_STAGE(PG8_SA(0, 1), cA + hstep, voffA);
    if (wr == 1) PG8_BAR;
    PG8_WAIT_V(4); PG8_BAR;
    PG8_STAGE(PG8_SB(1, 0), cB + kstep, voffB); PG8_STAGE(PG8_SA(1, 0), cA + kstep, voffA); PG8_STAGE(PG8_SB(1, 1), cB + hstep + kstep, voffB);
    PG8_WAIT_V(6); PG8_BAR;
    PG8_STAMP();
    for (;;) {
        const bool has_next = S.next(ui + 1, nxt);
        const char* nA = has_next ? (const char*)g.A + (size_t)nxt.pm * tstep : cA; const char* nB = has_next ? (const char*)g.Bt + (size_t)nxt.pn * tstep : cB;
        for (int t = 0; t < nt; t += 2) {
            const bool last = (t == nt - 2);
            const char* a1 = cA + (size_t)(t + 1) * kstep;
            const char* a2 = last ? nA : cA + (size_t)(t + 2) * kstep; const char* b2 = last ? nB : cB + (size_t)(t + 2) * kstep;
            const char* a3 = a2 + kstep; const char* b3 = b2 + kstep;
            if (last && has_next) S.a_ready(nxt);
            PG8_LDB(B0, 0, 0); PG8_SCHED; PG8_LDA(At, 0, 0); PG8_STAGE(PG8_SA(1, 1), a1 + hstep, voffA);
            PG8_WAIT_L(8); PG8_BAR; PG8_WAIT_L(0); PG8_MMA(0, 0, At, B0); PG8_BAR; PG8_SCHED;
            PG8_LDB(B1, 0, 1); PG8_STAGE(PG8_SB(0, 0), b2, voffB);
            PG8_BAR; PG8_WAIT_L(0); PG8_MMA(0, 1, At, B1); PG8_BAR;
            PG8_LDA(At, 0, 1); PG8_STAGE(PG8_SA(0, 0), a2, voffA);
            PG8_BAR; PG8_WAIT_L(0); PG8_MMA(1, 0, At, B0); PG8_BAR; PG8_SCHED;
            PG8_STAGE(PG8_SB(0, 1), b2 + hstep, voffB);
            PG8_WAIT_V(6); PG8_BAR; PG8_MMA(1, 1, At, B1); PG8_BAR;
            PG8_LDB(B0, 1, 0); PG8_SCHED; PG8_LDA(At, 1, 0); PG8_STAGE(PG8_SA(0, 1), a2 + hstep, voffA);
            PG8_WAIT_L(8); PG8_BAR; PG8_WAIT_L(0); PG8_MMA(0, 0, At, B0); PG8_BAR; PG8_SCHED;
            PG8_LDB(B1, 1, 1); PG8_STAGE(PG8_SB(1, 0), b3, voffB);
            PG8_BAR; PG8_WAIT_L(0); PG8_MMA(0, 1, At, B1); PG8_BAR;
            PG8_LDA(At, 1, 1); PG8_STAGE(PG8_SA(1, 0), a3, voffA);
            PG8_BAR; PG8_WAIT_L(0); PG8_MMA(1, 0, At, B0); PG8_BAR; PG8_SCHED;
            PG8_STAGE(PG8_SB(1, 1), b3 + hstep, voffB);
            PG8_WAIT_V(6); PG8_BAR; PG8_MMA(1, 1, At, B1); PG8_BAR;
        }
        PG8_STAMP();
        if constexpr (!Epi::AFTER_DRAIN) { E(acc, cur, wr, wc, fr, fq); S.done(cur); }
        PG8_STAMP();
        if (!has_next) break;
#pragma unroll
        for (int a = 0; a < 2; ++a)
#pragma unroll
            for (int b = 0; b < 2; ++b)
#pragma unroll
                for (int m = 0; m < 4; ++m)
#pragma unroll
                    for (int n = 0; n < 2; ++n) acc[a][b][m][n] = (f32x4){0.f, 0.f, 0.f, 0.f};
        cur = nxt; cA = nA; cB = nB; ++ui;
    }
    PG8_WAIT_V(0);
    if (wr == 0) PG8_BAR;
    PG8_BAR;
    if constexpr (Epi::AFTER_DRAIN) { E.fused(acc, cur, wr, wc, fr, fq, lds, wid, lane); S.done(cur); }
    PG8_STAMP();
    if (STAMP && wid == 0) { stamps[lane] = lane < nts ? (((unsigned long long)(unsigned)ts_hi << 32) | (unsigned)ts_lo) : 0ull;
        if (lane == 62) stamps[62] = rt_entry; if (lane == 63) stamps[63] = (unsigned long long)wall_clock64(); }
#undef PG8_STAMP
#undef PG8_SA
#undef PG8_SB
#undef PG8_STAGE
#undef PG8_LDA
#undef PG8_LDB
#undef PG8_MMA
#undef PG8_WAIT_V
#undef PG8_WAIT_L
#undef PG8_BAR
#undef PG8_SCHED
}
}

using pg8::bf16_t; using pg8::bf16x8; using pg8::f32x4; using pg8::u32x4; using pg8::Unit; using pg8::Gemm; using pg8::cvt_pk_bf16;
typedef unsigned u32x2 __attribute__((ext_vector_type(2)));
typedef short s16x4 __attribute__((ext_vector_type(4)));
#define LAS __attribute__((address_space(3)))

constexpr int MTOK = 65536, DM = 1024, DFF = 2816, NIN = 3080, NINP = 3328;
constexpr float EPS = 1e-6f;
constexpr size_t MiB = 1024ull * 1024ull;
constexpr size_t WS_XB = 0, WS_R1 = 128 * MiB, WS_DN = 512 * MiB, WS_MIX = 800 * MiB, WS_W = 928 * MiB;
constexpr size_t WS_BT1 = WS_W, WS_BT2 = WS_BT1 + 5632ull * 1024 * 2, WS_BT3 = WS_BT2 + 1024ull * 2816 * 2, WS_BT4 = WS_BT3 + 3328ull * 1024 * 2,
                 WS_BT5 = WS_BT4 + 1024ull * 1024 * 2, WS_BT6 = WS_BT5 + 5632ull * 1024 * 2, WS_WEND = WS_BT6 + 1024ull * 2816 * 2;
constexpr size_t WS_WC = 970 * MiB, WS_SSQ = 971 * MiB  , WS_BA = 987 * MiB  , WS_GL = 989 * MiB, WS_END = 990 * MiB;
static_assert(WS_WEND <= WS_WC, "weights overflow");
constexpr size_t WS_U = WS_R1, WS_V = WS_U + 64 * MiB, WS_QKV = WS_V + 64 * MiB, WS_Z = WS_QKV + 192 * MiB;

struct Params {
    const float* x; const float* ffn1_norm; const float* ffn1_wg; const float* ffn1_wu; const float* ffn1_wd; const float* mix_norm; const float* w_in; const float* conv_w;
    const float* a_log; const float* dt_bias; const float* dn_norm; const float* sg_ln_g; const float* sg_ln_b; const float* sg_w; const float* sg_b; const float* w_out;
    const float* ffn2_norm; const float* ffn2_wg; const float* ffn2_wu; const float* ffn2_wd; const float* final_norm;
    float* out; unsigned char* ws;
};

__device__ __forceinline__ unsigned short f2bf(float f) { unsigned u = __float_as_uint(f); u += 0x7fffu + ((u >> 16) & 1u); return (unsigned short)(u >> 16); }
__device__ __forceinline__ float bf2f(unsigned short b) { return __uint_as_float(((unsigned)b) << 16); }
__device__ __forceinline__ float bflo(unsigned w) { return __uint_as_float(w << 16); }
__device__ __forceinline__ float bfhi(unsigned w) { return __uint_as_float(w & 0xffff0000u); }
typedef __bf16 bf2_t __attribute__((ext_vector_type(2)));
typedef float f32x2 __attribute__((ext_vector_type(2)));
__device__ __forceinline__ unsigned pk(float a, float b) { f32x2 v = {a, b}; return __builtin_bit_cast(unsigned, __builtin_convertvector(v, bf2_t)); }
#define MFMA16(a, b, c) __builtin_amdgcn_mfma_f32_16x16x32_bf16((a), (b), (c), 0, 0, 0)
__device__ __forceinline__ float wave_sum(float v) {
#pragma unroll
    for (int o = 32; o > 0; o >>= 1) v += __shfl_xor(v, o, 64);
    return v;
}
__device__ __forceinline__ float silu_f(float v) { return v / (1.0f + __expf(-v)); }
__device__ __forceinline__ float gelu_tanh_f(float v) {
    const float u = 0.7978845608028654f * (v + 0.044715f * v * v * v);
    const float e = __expf(2.0f * u);
    const float t = 1.0f - 2.0f / (e + 1.0f);
    return 0.5f * v * (1.0f + t);
}
__device__ __forceinline__ float rstd_of(const float* ssq, int row) {
    const f32x4* p = (const f32x4*)(ssq + (size_t)row * 16);
    const f32x4 a = p[0], b = p[1], c = p[2], d = p[3];
    const float s = (a[0] + a[1] + a[2] + a[3]) + (b[0] + b[1] + b[2] + b[3]) + (c[0] + c[1] + c[2] + c[3]) + (d[0] + d[1] + d[2] + d[3]);
    return __builtin_amdgcn_rsqf(s * (1.0f / 1024.0f) + EPS);
}

struct EpiGateUp {
    static constexpr bool PERM = true, AFTER_DRAIN = false;
    bf16_t* act; const float* ssq;
    __device__ __forceinline__ void operator()(const f32x4 (&acc)[2][2][4][2], const Unit& u, int wr, int wc, int fr, int fq) const {
        const int row0 = u.pm * 256 + wr * 64 + fr, col0 = u.pn * 128 + wc * 32 + 8 * fq;
#pragma unroll
        for (int ai = 0; ai < 2; ++ai)
#pragma unroll
            for (int m = 0; m < 4; ++m) {
                const int row = row0 + ai * 128 + m * 16;
                const float rs = rstd_of(ssq, row);
                float o[8];
#pragma unroll
                for (int n = 0; n < 2; ++n)
#pragma unroll
                    for (int j = 0; j < 4; ++j) { const float g = acc[ai][0][m][n][j] * rs, uu = acc[ai][1][m][n][j] * rs; o[n * 4 + j] = silu_f(g) * uu; }
                u32x4 w; w.x = cvt_pk_bf16(o[0], o[1]); w.y = cvt_pk_bf16(o[2], o[3]); w.z = cvt_pk_bf16(o[4], o[5]); w.w = cvt_pk_bf16(o[6], o[7]);
                *(u32x4*)(act + (size_t)row * DFF + col0) = w;
            }
    }
};
struct EpiResid {
    static constexpr bool PERM = true, AFTER_DRAIN = false;
    const float* res; float* dst; bf16_t* xb; float* ssq; float alpha;
    __device__ __forceinline__ void operator()(const f32x4 (&acc)[2][2][4][2], const Unit& u, int wr, int wc, int fr, int fq) const {
        const int row0 = u.pm * 256 + wr * 64 + fr, col0 = u.pn * 256 + wc * 32 + 8 * fq;
#pragma unroll
        for (int ai = 0; ai < 2; ++ai)
#pragma unroll
            for (int m = 0; m < 4; ++m) {
                const int row = row0 + ai * 128 + m * 16;
                float sq = 0.f;
#pragma unroll
                for (int bj = 0; bj < 2; ++bj) {
                    const size_t off = (size_t)row * DM + col0 + bj * 128;
                    const f32x4 r0 = *(const f32x4*)(res + off), r1 = *(const f32x4*)(res + off + 4);
                    const f32x4 v0 = r0 + acc[ai][bj][m][0] * alpha, v1 = r1 + acc[ai][bj][m][1] * alpha;
                    *(f32x4*)(dst + off) = v0; *(f32x4*)(dst + off + 4) = v1;
                    sq += v0[0] * v0[0] + v0[1] * v0[1] + v0[2] * v0[2] + v0[3] * v0[3] + v1[0] * v1[0] + v1[1] * v1[1] + v1[2] * v1[2] + v1[3] * v1[3];
                    if (xb) { u32x4 w; w.x = cvt_pk_bf16(v0[0], v0[1]); w.y = cvt_pk_bf16(v0[2], v0[3]); w.z = cvt_pk_bf16(v1[0], v1[1]); w.w = cvt_pk_bf16(v1[2], v1[3]);
                        *(u32x4*)(xb + off) = w; }
                }
                sq += __shfl_xor(sq, 16, 64); sq += __shfl_xor(sq, 32, 64);
                if (fq == 0) ssq[(size_t)row * 16 + u.pn * 4 + wc] = sq;
            }
    }
};


struct EpiInProj {
    static constexpr bool PERM = true, AFTER_DRAIN = false;
    unsigned char* ws; const float* ssq; const float* a_log; const float* dt_bias;
    __device__ __forceinline__ void operator()(const f32x4 (&acc)[2][2][4][2], const Unit& u, int wr, int wc, int fr, int fq) const {
        const int row0 = u.pm * 256 + wr * 64 + fr, pn = u.pn;
        if (pn < 12) {
            bf16_t* base; int ld, colt, mode;
            if (pn < 2) { base = (bf16_t*)(ws + WS_U); ld = 512; colt = pn * 256; mode = 1; }
            else if (pn < 4) { base = (bf16_t*)(ws + WS_V); ld = 512; colt = (pn - 2) * 256; mode = 1; }
            else if (pn < 10) { base = (bf16_t*)(ws + WS_QKV); ld = 1536; colt = (pn - 4) * 256; mode = 0; }
            else { base = (bf16_t*)(ws + WS_Z); ld = 512; colt = (pn - 10) * 256; mode = 2; }
            const int col0 = colt + wc * 32 + 8 * fq;
#pragma unroll
            for (int ai = 0; ai < 2; ++ai)
#pragma unroll
                for (int m = 0; m < 4; ++m) {
                    const int row = row0 + ai * 128 + m * 16;
                    const float rs = rstd_of(ssq, row);
#pragma unroll
                    for (int bj = 0; bj < 2; ++bj) {
                        float o[8];
#pragma unroll
                        for (int n = 0; n < 2; ++n)
#pragma unroll
                            for (int j = 0; j < 4; ++j) { float v = acc[ai][bj][m][n][j] * rs; if (mode == 1) v = gelu_tanh_f(v); else if (mode == 2) v = silu_f(v); o[n * 4 + j] = v; }
                        u32x4 w; w.x = pk(o[0], o[1]); w.y = pk(o[2], o[3]); w.z = pk(o[4], o[5]); w.w = pk(o[6], o[7]);
                        *(u32x4*)(base + (size_t)row * ld + col0 + bj * 128) = w;
                    }
                }
        } else if (wc == 0 && fq == 0) {
            float* BA = (float*)(ws + WS_BA);
            const f32x4 al = *(const f32x4*)a_log, db = *(const f32x4*)dt_bias;
#pragma unroll
            for (int ai = 0; ai < 2; ++ai)
#pragma unroll
                for (int m = 0; m < 4; ++m) {
                    const int row = row0 + ai * 128 + m * 16;
                    const float rs = rstd_of(ssq, row);
                    f32x4 be, gg;
#pragma unroll
                    for (int j = 0; j < 4; ++j) {
                        const float bv = acc[ai][0][m][0][j] * rs, av = acc[ai][0][m][1][j] * rs + db[j];
                        be[j] = 1.0f / (1.0f + __expf(-bv));
                        const float sp = fmaxf(av, 0.f) + log1pf(__expf(-fabsf(av)));
                        gg[j] = -__expf(al[j]) * sp;
                    }
                    *(f32x4*)(BA + (size_t)row * 8) = be; *(f32x4*)(BA + (size_t)row * 8 + 4) = gg;
                }
        }
    }
};

#ifndef DNP_S1
#define DNP_S1 1
#endif
#ifndef DNP_S3
#define DNP_S3 1
#endif
#ifndef DNP_S4
#define DNP_S4 1
#endif
#ifndef DNP_S5
#define DNP_S5 1
#endif
constexpr int KS = 136;
constexpr int DN_ITEM = 36864;
constexpr int SLOT_BYTES = 69376;
__device__ __forceinline__ void phase_dnpre(const Params& p, unsigned char* shm) {
    unsigned char* ws = p.ws;
    const int tid = threadIdx.x, slot = tid >> 8, ts = tid & 255, sw = ts >> 6, lane = tid & 63, fr = lane & 15, fq = lane >> 4;
    unsigned char* sb = shm + slot * SLOT_BYTES;
    bf16_t* kb = (bf16_t*)sb; bf16_t* qb = (bf16_t*)(sb + 17408); bf16_t* vb = (bf16_t*)(sb + 34816);
    float* Lm = (float*)(sb + 52224); float* gcs = (float*)(sb + 68608); float* bts = (float*)(sb + 68864); float* bes = (float*)(sb + 69120);
    const bf16_t* QKV = (const bf16_t*)(ws + WS_QKV); const float* BA = (const float*)(ws + WS_BA);
    bf16_t* DN = (bf16_t*)(ws + WS_DN); float* GL = (float*)(ws + WS_GL);
    for (int it0 = blockIdx.x * 2; it0 < 4096; it0 += gridDim.x * 2) {
        const int item = it0 + slot, bh = item >> 5, n = item & 31, b = bh >> 2, h = bh & 3;
        const int row0 = b * 2048 + n * 64;
        bf16_t* Dg = DN + (size_t)item * DN_ITEM; bf16_t* Wg = Dg; bf16_t* Qdg = Dg + 8192; bf16_t* KdTg = Dg + 16384; bf16_t* UTg = Dg + 24576; bf16_t* QKg = Dg + 32768;
#if DNP_S1
        {
            const int cq = h * 128 + 2 * lane;
            float w[4][6];
#pragma unroll
            for (int j = 0; j < 4; ++j)
#pragma unroll
                for (int s = 0; s < 3; ++s) { const f32x2 t = *(const f32x2*)(p.conv_w + j * 1536 + s * 512 + cq); w[j][2 * s] = t.x; w[j][2 * s + 1] = t.y; }
            float xm[3][6];
            const int tt0 = sw * 16;
#pragma unroll
            for (int r = 0; r < 3; ++r) {
                const int pos = n * 64 + tt0 - 3 + r;
#pragma unroll
                for (int s = 0; s < 3; ++s) {
                    unsigned v = 0u; if (pos >= 0) v = *(const unsigned*)(QKV + (size_t)(b * 2048 + pos) * 1536 + s * 512 + cq);
                    xm[r][2 * s] = bflo(v); xm[r][2 * s + 1] = bfhi(v); }
            }
#pragma unroll
            for (int i = 0; i < 16; ++i) {
                const int row = row0 + tt0 + i;
                float x0[6], y[6];
#pragma unroll
                for (int s = 0; s < 3; ++s) { const unsigned v = *(const unsigned*)(QKV + (size_t)row * 1536 + s * 512 + cq); x0[2 * s] = bflo(v); x0[2 * s + 1] = bfhi(v); }
#pragma unroll
                for (int c = 0; c < 6; ++c) { const float t = w[0][c] * xm[0][c] + w[1][c] * xm[1][c] + w[2][c] * xm[2][c] + w[3][c] * x0[c]; y[c] = silu_f(t); }
                const float sq = wave_sum(y[0] * y[0] + y[1] * y[1]), sk = wave_sum(y[2] * y[2] + y[3] * y[3]);
                const float rq = __builtin_amdgcn_rsqf(sq + EPS) * 0.08838834764831845f, rk = __builtin_amdgcn_rsqf(sk + EPS);
                *(unsigned*)(qb + (tt0 + i) * KS + 2 * lane) = pk(y[0] * rq, y[1] * rq);
                *(unsigned*)(kb + (tt0 + i) * KS + 2 * lane) = pk(y[2] * rk, y[3] * rk);
                *(unsigned*)(vb + (tt0 + i) * KS + 2 * lane) = pk(y[4], y[5]);
#pragma unroll
                for (int c = 0; c < 6; ++c) { xm[0][c] = xm[1][c]; xm[1][c] = xm[2][c]; xm[2][c] = x0[c]; }
            }
        }
#endif
        if (sw == 0) {
            const float beta = BA[(size_t)(row0 + lane) * 8 + h]; float g = BA[(size_t)(row0 + lane) * 8 + 4 + h];
#pragma unroll
            for (int o = 1; o < 64; o <<= 1) { const float t = __shfl_up(g, o, 64); if (lane >= o) g += t; }
            gcs[lane] = g; bts[lane] = beta; bes[lane] = beta * __expf(g);
        }
        __syncthreads();
#if DNP_S3
        {
            bf16x8 ak[4], aq[4];
#pragma unroll
            for (int kk = 0; kk < 4; ++kk) { ak[kk] = *(const bf16x8*)(kb + (16 * sw + fr) * KS + 32 * kk + 8 * fq); aq[kk] = *(const bf16x8*)(qb + (16 * sw + fr) * KS + 32 * kk + 8 * fq); }
            float gci[4], bi[4];
#pragma unroll
            for (int r = 0; r < 4; ++r) { gci[r] = gcs[16 * sw + 4 * fq + r]; bi[r] = bts[16 * sw + 4 * fq + r]; }
#pragma unroll
            for (int jt = 0; jt < 4; ++jt) {
                if (jt <= sw) {
                    f32x4 dk = {0.f, 0.f, 0.f, 0.f}, dq = {0.f, 0.f, 0.f, 0.f};
#pragma unroll
                    for (int kk = 0; kk < 4; ++kk) { const bf16x8 bb = *(const bf16x8*)(kb + (16 * jt + fr) * KS + 32 * kk + 8 * fq); dk = MFMA16(ak[kk], bb, dk); dq = MFMA16(aq[kk], bb, dq); }
                    const int j = 16 * jt + fr; const float gcj = gcs[j];
#pragma unroll
                    for (int r = 0; r < 4; ++r) {
                        const int i = 16 * sw + 4 * fq + r; const float dec = __expf(gci[r] - gcj);
                        Lm[i * 64 + j] = (i > j) ? bi[r] * dk[r] * dec : 0.f;
                        const float qv = (i >= j) ? dq[r] * dec : 0.f;
                        QKg[i * 64 + j] = (bf16_t)(pk(qv, 0.f) & 0xffffu);
                    }
                } else {
#pragma unroll
                    for (int r = 0; r < 4; ++r) QKg[(16 * sw + 4 * fq + r) * 64 + 16 * jt + fr] = (bf16_t)0;
                }
            }
        }
#endif
        __syncthreads();
#if DNP_S5
        {
            const float gl_last = gcs[63];
#pragma unroll
            for (int rep = 0; rep < 4; ++rep) {
                const int chunk = ts + 256 * rep, i = chunk >> 4, d0 = (chunk & 15) * 8;
                const u32x4 v = *(const u32x4*)(qb + i * KS + d0); const float s = __expf(gcs[i]);
                u32x4 w; w.x = pk(bflo(v.x) * s, bfhi(v.x) * s); w.y = pk(bflo(v.y) * s, bfhi(v.y) * s); w.z = pk(bflo(v.z) * s, bfhi(v.z) * s); w.w = pk(bflo(v.w) * s, bfhi(v.w) * s);
                *(u32x4*)(Qdg + i * 128 + d0) = w;
            }
            const int d = ts & 127, half = ts >> 7;
#pragma unroll
            for (int i8 = 0; i8 < 4; ++i8) {
                float o[8];
#pragma unroll
                for (int e = 0; e < 8; ++e) { const int i = 32 * half + 8 * i8 + e; o[e] = bf2f(kb[i * KS + d]) * __expf(gl_last - gcs[i]); }
                u32x4 w; w.x = pk(o[0], o[1]); w.y = pk(o[2], o[3]); w.z = pk(o[4], o[5]); w.w = pk(o[6], o[7]);
                *(u32x4*)(KdTg + d * 64 + 32 * half + 8 * i8) = w;
            }
            if (ts == 0) GL[item] = __expf(gl_last);
        }
#endif
#if DNP_S4
        {
            const bool isU = ts < 128; const bf16_t* srcb = isU ? vb : kb; const float* scl = isU ? bts : bes; const int cc = ts & 127;
            float x[64];
#pragma unroll
            for (int i = 0; i < 64; ++i) {
                float rhs = bf2f(srcb[i * KS + cc]) * scl[i];
                int z = 0; if (i > 0) asm("v_and_b32 %0, 0, %1" : "=v"(z) : "v"(x[i - 1]));
                const f32x4* Lr = (const f32x4*)(Lm + i * 64 + z);
#pragma unroll
                for (int j4 = 0; j4 * 4 < i; ++j4) {
                    const f32x4 l = Lr[j4];
#pragma unroll
                    for (int e = 0; e < 4; ++e) if (j4 * 4 + e < i) rhs -= l[e] * x[j4 * 4 + e];
                }
                x[i] = rhs;
            }
            if (isU) {
#pragma unroll
                for (int i8 = 0; i8 < 8; ++i8) { u32x4 w; w.x = pk(x[8 * i8], x[8 * i8 + 1]); w.y = pk(x[8 * i8 + 2], x[8 * i8 + 3]); w.z = pk(x[8 * i8 + 4], x[8 * i8 + 5]); w.w = pk(x[8 * i8 + 6], x[8 * i8 + 7]);
                    *(u32x4*)(UTg + cc * 64 + 8 * i8) = w; }
            } else {
#pragma unroll
                for (int i = 0; i < 64; ++i) Wg[i * 128 + cc] = (bf16_t)(pk(x[i], 0.f) & 0xffffu);
            }
        }
#endif
        __syncthreads();
    }
}

__device__ __forceinline__ bf16x8 ldfrag_perm(const bf16_t* rp, int fq) {
    const u32x2 lo = *(const u32x2*)(rp + 4 * fq), hi = *(const u32x2*)(rp + 16 + 4 * fq);
    u32x4 w; w.x = lo.x; w.y = lo.y; w.z = hi.x; w.w = hi.y; return __builtin_bit_cast(bf16x8, w);
}
__device__ __forceinline__ bf16x8 pack2(const f32x4 a, const f32x4 b) { u32x4 w; w.x = pk(a[0], a[1]); w.y = pk(a[2], a[3]); w.z = pk(b[0], b[1]); w.w = pk(b[2], b[3]); return __builtin_bit_cast(bf16x8, w); }
__device__ __forceinline__ void scan_bh(const Params& p, unsigned char* shm, int bh) {
    unsigned char* ws = p.ws;
    const int tid = threadIdx.x, wid = tid >> 6, lane = tid & 63, fr = lane & 15, fq = lane >> 4;
    const int b = bh >> 2, h = bh & 3, e0 = wid * 16;
    float* Ob = (float*)shm;
    const bf16_t* DN = (const bf16_t*)(ws + WS_DN); const float* GL = (const float*)(ws + WS_GL); const bf16_t* Zb = (const bf16_t*)(ws + WS_Z); bf16_t* MIX = (bf16_t*)(ws + WS_MIX);
    const int ec = tid >> 3, ee = (tid & 7) * 16;
    f32x4 dnw[4];
#pragma unroll
    for (int i = 0; i < 4; ++i) dnw[i] = *(const f32x4*)(p.dn_norm + ee + 4 * i);
    f32x4 S[8];
#pragma unroll
    for (int i = 0; i < 8; ++i) S[i] = (f32x4){0.f, 0.f, 0.f, 0.f};
    for (int n = 0; n < 32; ++n) {
        const int item = bh * 32 + n; const bf16_t* Dg = DN + (size_t)item * DN_ITEM;
        const bf16_t* Wg = Dg; const bf16_t* Qdg = Dg + 8192; const bf16_t* KdTg = Dg + 16384; const bf16_t* UTg = Dg + 24576; const bf16_t* QKg = Dg + 32768;
        const float gl = GL[item];
        bf16x8 SB[4];
#pragma unroll
        for (int kb = 0; kb < 4; ++kb) SB[kb] = pack2(S[2 * kb], S[2 * kb + 1]);
        f32x4 Vn[4], O[4];
#pragma unroll
        for (int ct = 0; ct < 4; ++ct) {
            f32x4 P = {0.f, 0.f, 0.f, 0.f}, Oq = {0.f, 0.f, 0.f, 0.f};
            const bf16_t* wrp = Wg + (16 * ct + fr) * 128; const bf16_t* qrp = Qdg + (16 * ct + fr) * 128;
#pragma unroll
            for (int kb = 0; kb < 4; ++kb) { P = MFMA16(ldfrag_perm(wrp + 32 * kb, fq), SB[kb], P); Oq = MFMA16(ldfrag_perm(qrp + 32 * kb, fq), SB[kb], Oq); }
            const u32x2 uu = *(const u32x2*)(UTg + (e0 + fr) * 64 + 16 * ct + 4 * fq);
            Vn[ct] = (f32x4){bflo(uu.x) - P[0], bfhi(uu.x) - P[1], bflo(uu.y) - P[2], bfhi(uu.y) - P[3]}; O[ct] = Oq;
        }
        bf16x8 VB[2]; VB[0] = pack2(Vn[0], Vn[1]); VB[1] = pack2(Vn[2], Vn[3]);
#pragma unroll
        for (int ct = 0; ct < 4; ++ct)
#pragma unroll
            for (int kc = 0; kc < 2; ++kc) O[ct] = MFMA16(ldfrag_perm(QKg + (16 * ct + fr) * 64 + 32 * kc, fq), VB[kc], O[ct]);
#pragma unroll
        for (int dt = 0; dt < 8; ++dt) {
            f32x4 a = S[dt] * gl;
#pragma unroll
            for (int kc = 0; kc < 2; ++kc) a = MFMA16(ldfrag_perm(KdTg + (16 * dt + fr) * 64 + 32 * kc, fq), VB[kc], a);
            S[dt] = a;
        }
        float* ob = Ob + (n & 1) * (64 * 132);
#pragma unroll
        for (int ct = 0; ct < 4; ++ct)
#pragma unroll
            for (int r = 0; r < 4; ++r) ob[(16 * ct + 4 * fq + r) * 132 + e0 + fr] = O[ct][r];
        __syncthreads();
        {
            f32x4 o4[4]; float ss = 0.f;
#pragma unroll
            for (int i = 0; i < 4; ++i) { o4[i] = *(const f32x4*)(ob + ec * 132 + ee + 4 * i); ss += o4[i][0] * o4[i][0] + o4[i][1] * o4[i][1] + o4[i][2] * o4[i][2] + o4[i][3] * o4[i][3]; }
            ss += __shfl_xor(ss, 1, 64); ss += __shfl_xor(ss, 2, 64); ss += __shfl_xor(ss, 4, 64);
            const float rs = __builtin_amdgcn_rsqf(ss * (1.0f / 128.0f) + EPS);
            const size_t row = (size_t)b * 2048 + n * 64 + ec;
            const u32x4 z0 = *(const u32x4*)(Zb + row * 512 + h * 128 + ee), z1 = *(const u32x4*)(Zb + row * 512 + h * 128 + ee + 8);
            const unsigned zz[8] = {z0.x, z0.y, z0.z, z0.w, z1.x, z1.y, z1.z, z1.w};
            unsigned ow[8];
#pragma unroll
            for (int i = 0; i < 4; ++i) {
                const f32x4 v = o4[i] * rs * dnw[i];
                ow[2 * i] = pk(v[0] * bflo(zz[2 * i]), v[1] * bfhi(zz[2 * i])); ow[2 * i + 1] = pk(v[2] * bflo(zz[2 * i + 1]), v[3] * bfhi(zz[2 * i + 1]));
            }
            u32x4 w0, w1; w0.x = ow[0]; w0.y = ow[1]; w0.z = ow[2]; w0.w = ow[3]; w1.x = ow[4]; w1.y = ow[5]; w1.z = ow[6]; w1.w = ow[7];
            *(u32x4*)(MIX + row * 1024 + 512 + h * 128 + ee) = w0; *(u32x4*)(MIX + row * 1024 + 512 + h * 128 + ee + 8) = w1;
        }
    }
}

__device__ __forceinline__ void sg_item(const Params& p, unsigned char* shm, int item) {
    unsigned char* ws = p.ws;
    const int tid = threadIdx.x, wid = tid >> 6, lane = tid & 63, fr = lane & 15, fq = lane >> 4;
    const int r0 = item * 128;
    bf16_t* vT = (bf16_t*)shm;
    const bf16_t* Vg = (const bf16_t*)(ws + WS_V); const bf16_t* Ug = (const bf16_t*)(ws + WS_U); const bf16_t* Wc = (const bf16_t*)(ws + WS_WC); bf16_t* MIX = (bf16_t*)(ws + WS_MIX);
    float lg[8], lb[8];
#pragma unroll
    for (int j = 0; j < 8; ++j) { lg[j] = p.sg_ln_g[lane + 64 * j]; lb[j] = p.sg_ln_b[lane + 64 * j]; }
    for (int ip = 0; ip < 8; ++ip) {
        const int s = wid * 16 + 2 * ip;
        float a0[8], a1[8]; float s0 = 0.f, s1 = 0.f;
#pragma unroll
        for (int j = 0; j < 8; ++j) { a0[j] = bf2f(Vg[(size_t)(r0 + s) * 512 + lane + 64 * j]); a1[j] = bf2f(Vg[(size_t)(r0 + s + 1) * 512 + lane + 64 * j]); s0 += a0[j]; s1 += a1[j]; }
        const float m0 = wave_sum(s0) * (1.0f / 512.0f), m1 = wave_sum(s1) * (1.0f / 512.0f);
        float q0 = 0.f, q1 = 0.f;
#pragma unroll
        for (int j = 0; j < 8; ++j) { a0[j] -= m0; a1[j] -= m1; q0 += a0[j] * a0[j]; q1 += a1[j] * a1[j]; }
        const float rs0 = __builtin_amdgcn_rsqf(wave_sum(q0) * (1.0f / 512.0f) + EPS), rs1 = __builtin_amdgcn_rsqf(wave_sum(q1) * (1.0f / 512.0f) + EPS);
#pragma unroll
        for (int j = 0; j < 8; ++j) *(unsigned*)(vT + (lane + 64 * j) * KS + s) = pk(a0[j] * rs0 * lg[j] + lb[j], a1[j] * rs1 * lg[j] + lb[j]);
    }
    __syncthreads();
    const int g = wid, cg0 = g * 64;
    for (int mt = 0; mt < 8; ++mt) {
        f32x4 acc[4];
#pragma unroll
        for (int nt = 0; nt < 4; ++nt) acc[nt] = (f32x4){0.f, 0.f, 0.f, 0.f};
#pragma unroll
        for (int ks = 0; ks < 4; ++ks) {
            if (32 * ks <= 16 * mt + 15) {
                const bf16x8 wf = *(const bf16x8*)(Wc + (size_t)(g * 128 + 16 * mt + fr) * 128 + 32 * ks + 8 * fq);
#pragma unroll
                for (int nt = 0; nt < 4; ++nt) { const bf16x8 vf = *(const bf16x8*)(vT + (cg0 + 16 * nt + fr) * KS + 32 * ks + 8 * fq); acc[nt] = MFMA16(vf, wf, acc[nt]); }
            }
        }
        const int t = 16 * mt + fr; const size_t row = (size_t)r0 + t; const float bs = p.sg_b[g * 128 + t];
#pragma unroll
        for (int nt = 0; nt < 4; ++nt) {
            const int cbase = cg0 + 16 * nt + 4 * fq;
            const u32x2 uu = *(const u32x2*)(Ug + row * 512 + cbase);
            u32x2 w; w.x = pk(bflo(uu.x) * (acc[nt][0] + bs), bfhi(uu.x) * (acc[nt][1] + bs)); w.y = pk(bflo(uu.y) * (acc[nt][2] + bs), bfhi(uu.y) * (acc[nt][3] + bs));
            *(u32x2*)(MIX + row * 1024 + cbase) = w;
        }
    }
    __syncthreads();
}
__device__ __forceinline__ void phase_scan_sg(const Params& p, unsigned char* shm) {
    if (blockIdx.x < 128) scan_bh(p, shm, blockIdx.x);
    else for (int it = blockIdx.x - 128; it < 512; it += gridDim.x - 128) sg_item(p, shm, it);
}

__device__ __forceinline__ void prep_tile(const float* __restrict__ src, int K, int N, bf16_t* __restrict__ dst, int blk, int bstride, int boff, const float* __restrict__ scale,
                                          int tk, int tn, float* tile) {
    const int t = threadIdx.x, nl = t & 63, n = tn * 64 + nl;
#pragma unroll
    for (int i = 0; i < 8; ++i) { const int kk = (t >> 6) + 8 * i, k = tk * 64 + kk; float v = (n < N) ? src[(size_t)k * N + n] : 0.f; if (scale) v *= scale[k]; tile[kk * 65 + nl] = v; }
    __syncthreads();
    const int nn = t >> 3, kg = t & 7, nrow = tn * 64 + nn, drow = (nrow / blk) * bstride + (nrow % blk) + boff;
    float o[8];
#pragma unroll
    for (int j = 0; j < 8; ++j) o[j] = tile[(kg * 8 + j) * 65 + nn];
    u32x4 w; w.x = cvt_pk_bf16(o[0], o[1]); w.y = cvt_pk_bf16(o[2], o[3]); w.z = cvt_pk_bf16(o[4], o[5]); w.w = cvt_pk_bf16(o[6], o[7]);
    *(u32x4*)(dst + (size_t)drow * K + tk * 64 + kg * 8) = w;
    __syncthreads();
}
__device__ __forceinline__ void phase_prep(const Params& p, float* tile) {
    unsigned char* ws = p.ws;
    constexpr int BIG = 1 << 30;
    for (int tix = blockIdx.x; tix < 5312; tix += gridDim.x) {
        int j = tix; const float* src; int K, N, NP; bf16_t* dst; int blk = BIG, bs = 0, boff = 0; const float* scale = nullptr;
        if (j < 704) { src = p.ffn1_wg; K = 1024; N = NP = 2816; dst = (bf16_t*)(ws + WS_BT1); blk = 128; bs = 256; scale = p.ffn1_norm; }
        else if ((j -= 704) < 704) { src = p.ffn1_wu; K = 1024; N = NP = 2816; dst = (bf16_t*)(ws + WS_BT1); blk = 128; bs = 256; boff = 128; scale = p.ffn1_norm; }
        else if ((j -= 704) < 704) { src = p.ffn1_wd; K = 2816; N = NP = 1024; dst = (bf16_t*)(ws + WS_BT2); }
        else if ((j -= 704) < 832) { src = p.w_in; K = 1024; N = NIN; NP = NINP; dst = (bf16_t*)(ws + WS_BT3); scale = p.mix_norm; }
        else if ((j -= 832) < 256) { src = p.w_out; K = 1024; N = NP = 1024; dst = (bf16_t*)(ws + WS_BT4); }
        else if ((j -= 256) < 704) { src = p.ffn2_wg; K = 1024; N = NP = 2816; dst = (bf16_t*)(ws + WS_BT5); blk = 128; bs = 256; scale = p.ffn2_norm; }
        else if ((j -= 704) < 704) { src = p.ffn2_wu; K = 1024; N = NP = 2816; dst = (bf16_t*)(ws + WS_BT5); blk = 128; bs = 256; boff = 128; scale = p.ffn2_norm; }
        else { j -= 704; src = p.ffn2_wd; K = 2816; N = NP = 1024; dst = (bf16_t*)(ws + WS_BT6); }
        const int ntn = NP / 64, tk = j / ntn, tn = j % ntn;
        prep_tile(src, K, N, dst, blk, bs, boff, scale, tk, tn, tile);
    }
    { bf16_t* wc = (bf16_t*)(ws + WS_WC);
      for (int i = blockIdx.x * 512 + threadIdx.x; i < 8 * 128 * 128; i += gridDim.x * 512) { const int t = (i >> 7) & 127, s = i & 127; wc[i] = (t >= s) ? f2bf(p.sg_w[i]) : (bf16_t)0; } }
    { bf16_t* xb = (bf16_t*)(ws + WS_XB); float* ssq = (float*)(ws + WS_SSQ);
      const int wid = threadIdx.x >> 6, lane = threadIdx.x & 63;
      for (int row = blockIdx.x * 8 + wid; row < MTOK; row += gridDim.x * 8) {
          const f32x4* xr = (const f32x4*)(p.x + (size_t)row * DM); float s = 0.f;
#pragma unroll
          for (int i = 0; i < 4; ++i) { const f32x4 v = xr[lane + 64 * i]; s += v[0] * v[0] + v[1] * v[1] + v[2] * v[2] + v[3] * v[3];
              u32x2 w; w.x = cvt_pk_bf16(v[0], v[1]); w.y = cvt_pk_bf16(v[2], v[3]); *(u32x2*)(xb + (size_t)row * DM + (lane + 64 * i) * 4) = w; }
          s = wave_sum(s);
          if (lane < 16) ssq[(size_t)row * 16 + lane] = (lane == 0) ? s : 0.f;
      } }
}
__device__ __forceinline__ void phase_final(const Params& p) {
    const float* ssq = (const float*)(p.ws + WS_SSQ + 3 * 4 * MiB);
    const int wid = threadIdx.x >> 6, lane = threadIdx.x & 63;
    f32x4 g[4];
#pragma unroll
    for (int i = 0; i < 4; ++i) g[i] = ((const f32x4*)p.final_norm)[lane + 64 * i];
    for (int row = blockIdx.x * 8 + wid; row < MTOK; row += gridDim.x * 8) {
        float s = ssq[(size_t)row * 16 + (lane & 15)];
        s += __shfl_xor(s, 1, 64); s += __shfl_xor(s, 2, 64); s += __shfl_xor(s, 4, 64); s += __shfl_xor(s, 8, 64);
        const float rs = __builtin_amdgcn_rsqf(s * (1.0f / 1024.0f) + EPS);
        f32x4* o = (f32x4*)(p.out + (size_t)row * DM);
#pragma unroll
        for (int i = 0; i < 4; ++i) { f32x4 v = o[lane + 64 * i]; v = v * rs * g[i]; o[lane + 64 * i] = v; }
    }
}

constexpr int LDS_BYTES = 144 * 1024;
constexpr int NPHASE = 10;
template <int PH> __device__ __forceinline__ void run_phase(const Params& p, unsigned char* shm) {
    unsigned char* ws = p.ws;
    pg8::StaticOrder S;
    float* ssq0 = (float*)(ws + WS_SSQ); float* ssq1 = (float*)(ws + WS_SSQ + 4 * MiB); float* ssq2 = (float*)(ws + WS_SSQ + 8 * MiB); float* ssq3 = (float*)(ws + WS_SSQ + 12 * MiB);
    if constexpr (PH == 0) { phase_prep(p, (float*)shm); }
    if constexpr (PH == 1) {
        Gemm g{(const bf16_t*)(ws + WS_XB), (const bf16_t*)(ws + WS_BT1), MTOK, 2 * DFF, DM}; S.init(g.M, g.N, (int)gridDim.x, (int)blockIdx.x);
        EpiGateUp E{(bf16_t*)(ws + WS_R1), ssq0};
        pg8::gemm_phase<EpiGateUp, pg8::StaticOrder, false>((PG8_LAS unsigned char*)shm, g, S, E, nullptr);
    }
    if constexpr (PH == 2) {
        Gemm g{(const bf16_t*)(ws + WS_R1), (const bf16_t*)(ws + WS_BT2), MTOK, DM, DFF}; S.init(g.M, g.N, (int)gridDim.x, (int)blockIdx.x);
        EpiResid E{p.x, p.out, (bf16_t*)(ws + WS_XB), ssq1, 0.5f};
        pg8::gemm_phase<EpiResid, pg8::StaticOrder, false>((PG8_LAS unsigned char*)shm, g, S, E, nullptr);
    }
    if constexpr (PH == 3) {
        Gemm g{(const bf16_t*)(ws + WS_XB), (const bf16_t*)(ws + WS_BT3), MTOK, NINP, DM}; S.init(g.M, g.N, (int)gridDim.x, (int)blockIdx.x);
        EpiInProj E{ws, ssq1, p.a_log, p.dt_bias};
        pg8::gemm_phase<EpiInProj, pg8::StaticOrder, false>((PG8_LAS unsigned char*)shm, g, S, E, nullptr);
    }
    if constexpr (PH == 4) { phase_dnpre(p, shm); }
    if constexpr (PH == 5) { phase_scan_sg(p, shm); }
    if constexpr (PH == 6) {
        Gemm g{(const bf16_t*)(ws + WS_MIX), (const bf16_t*)(ws + WS_BT4), MTOK, DM, DM}; S.init(g.M, g.N, (int)gridDim.x, (int)blockIdx.x);
        EpiResid E{p.out, p.out, (bf16_t*)(ws + WS_XB), ssq2, 1.0f};
        pg8::gemm_phase<EpiResid, pg8::StaticOrder, false>((PG8_LAS unsigned char*)shm, g, S, E, nullptr);
    }
    if constexpr (PH == 7) {
        Gemm g{(const bf16_t*)(ws + WS_XB), (const bf16_t*)(ws + WS_BT5), MTOK, 2 * DFF, DM}; S.init(g.M, g.N, (int)gridDim.x, (int)blockIdx.x);
        EpiGateUp E{(bf16_t*)(ws + WS_R1), ssq2};
        pg8::gemm_phase<EpiGateUp, pg8::StaticOrder, false>((PG8_LAS unsigned char*)shm, g, S, E, nullptr);
    }
    if constexpr (PH == 8) {
        Gemm g{(const bf16_t*)(ws + WS_R1), (const bf16_t*)(ws + WS_BT6), MTOK, DM, DFF}; S.init(g.M, g.N, (int)gridDim.x, (int)blockIdx.x);
        EpiResid E{p.out, p.out, nullptr, ssq3, 0.5f};
        pg8::gemm_phase<EpiResid, pg8::StaticOrder, false>((PG8_LAS unsigned char*)shm, g, S, E, nullptr);
    }
    if constexpr (PH == 9) { phase_final(p); }
}
template <int PH> __global__ __launch_bounds__(512, 2) void k_phase(Params p) {
    extern __shared__ __attribute__((aligned(16))) unsigned char shm[];
    run_phase<PH>(p, shm);
}
__global__ __launch_bounds__(512, 2) void k_mega(Params p) {
    extern __shared__ __attribute__((aligned(16))) unsigned char shm[];
    cg::grid_group grid = cg::this_grid();
    run_phase<0>(p, shm); grid.sync();
    run_phase<1>(p, shm); grid.sync();
    run_phase<2>(p, shm); grid.sync();
    run_phase<3>(p, shm); grid.sync();
    run_phase<4>(p, shm); grid.sync();
    run_phase<5>(p, shm); grid.sync();
    run_phase<6>(p, shm); grid.sync();
    run_phase<7>(p, shm); grid.sync();
    run_phase<8>(p, shm); grid.sync();
    run_phase<9>(p, shm);
}

#ifndef MEGA
#define MEGA 1
#endif
template <int PH> static void launch_phase(const Params& p, hipStream_t stream) {
    static bool attr = false;
    if (!attr) { (void)hipFuncSetAttribute((const void*)k_phase<PH>, hipFuncAttributeMaxDynamicSharedMemorySize, LDS_BYTES); attr = true; }
    hipLaunchKernelGGL(k_phase<PH>, dim3(256), dim3(512), LDS_BYTES, stream, p);
}
extern "C" void kernel_launch(void* const* d_in, const int* in_sizes, int n_in, void* d_out, int out_size, void* d_ws, size_t ws_size, hipStream_t stream) {
    Params p{};
    const float** f = (const float**)&p;
    for (int i = 0; i < 21; ++i) f[i] = (const float*)d_in[i];
    p.out = (float*)d_out; p.ws = (unsigned char*)d_ws;
    if (ws_size < WS_END) { fprintf(stderr, "kernel_launch: workspace too small: %zu < %zu\n", ws_size, (size_t)WS_END); return; }
#if MEGA
    static int grid = 0;
    if (!grid) {
        (void)hipFuncSetAttribute((const void*)k_mega, hipFuncAttributeMaxDynamicSharedMemorySize, LDS_BYTES);
        int dev = 0, cus = 0, per_cu = 0; (void)hipGetDevice(&dev); (void)hipDeviceGetAttribute(&cus, hipDeviceAttributeMultiprocessorCount, dev);
        (void)hipOccupancyMaxActiveBlocksPerMultiprocessor(&per_cu, (const void*)k_mega, 512, LDS_BYTES);
        if (per_cu < 1) fprintf(stderr, "kernel_launch: occupancy query says %d blocks per CU\n", per_cu);
        grid = cus;
    }
    void* args[] = {(void*)&p};
    hipError_t e = hipLaunchCooperativeKernel((const void*)k_mega, dim3(grid), dim3(512), args, LDS_BYTES, stream);
    if (e != hipSuccess) fprintf(stderr, "cooperative launch failed: %s (grid %d)\n", hipGetErrorString(e), grid);
#else
    launch_phase<0>(p, stream); launch_phase<1>(p, stream); launch_phase<2>(p, stream); launch_phase<3>(p, stream); launch_phase<4>(p, stream); launch_phase<5>(p, stream); launch_phase<6>(p, stream); launch_phase<7>(p, stream); launch_phase<8>(p, stream); launch_phase<9>(p, stream);
#endif
}
```

```cpp
#include <hip/hip_runtime.h>
#include <hip/hip_cooperative_groups.h>
#include <cstdio>
namespace cg = cooperative_groups;
__device__ __forceinline__ int otid() { int t = (int)threadIdx.x; asm volatile("" : "+v"(t)); return t; }
namespace pg8 {
#define PG8_LAS __attribute__((address_space(3)))
typedef unsigned short bf16_t;
typedef short bf16x8 __attribute__((ext_vector_type(8)));
typedef float f32x4 __attribute__((ext_vector_type(4)));
typedef unsigned u32x4 __attribute__((ext_vector_type(4)));
constexpr int BM = 256, BK = 64, HALF = 128, HTB = HALF * BK * 2  , STAGE_BYTES = 8 * HTB, NXCD = 8, WGM = 4;

__host__ __device__ __forceinline__ int lds_byte(int r, int c) { const int st = (r >> 4) * 2 + (c >> 5), rr = r & 15, cc = c & 31, ob = rr * 64 + cc * 2; return st * 1024 + (ob ^ (((ob >> 9) & 1) << 5)); }
__host__ __device__ __forceinline__ void stage_rc(int b, int& R, int& C) { const int st = b / 1024, sb = b % 1024, swz = sb ^ (((sb >> 9) & 1) << 5); R = (st >> 1) * 16 + swz / 64; C = (st & 1) * 32 + (swz % 64) / 2; }
__host__ __device__ __forceinline__ int perm32(int rho) { const int n = rho >> 4, i = rho & 15; return 8 * (i >> 2) + 4 * n + (i & 3); }

struct Unit { int pm, pn; };
struct Gemm { const bf16_t* A; const bf16_t* Bt; int M, N, K; };

struct StaticOrder {
    int nM, nN, nwg, G, c;
    __host__ __device__ void init(int M, int N, int G_, int c_) { nM = M / BM; nN = N / BM; nwg = nM * nN; G = G_; c = c_; }
    __host__ __device__ bool next(int i, Unit& u) const {
        const long L = (long)i * G + c; if (L >= nwg) return false;
        int wgid = (int)L; { const int q = nwg / NXCD, r = nwg % NXCD, xcd = wgid % NXCD, off = wgid / NXCD; wgid = (xcd < r ? xcd * (q + 1) : r * (q + 1) + (xcd - r) * q) + off; }
        const int nig = WGM * nN, gid = wgid / nig, fm = gid * WGM, gsz = (nM - fm) < WGM ? (nM - fm) : WGM;
        u.pm = fm + ((wgid % nig) % gsz); u.pn = (wgid % nig) / gsz; return true;
    }
    __device__ __forceinline__ void a_ready(const Unit&) const {}
    __device__ __forceinline__ void done(const Unit&) const {}
};
__device__ __forceinline__ unsigned cvt_pk_bf16(float lo, float hi) { unsigned r; asm volatile("v_cvt_pk_bf16_f32 %0, %1, %2" : "=v"(r) : "v"(lo), "v"(hi)); return r; }
template <class Epi, class Sched, bool STAMP = false>
__device__ __forceinline__ void gemm_phase(PG8_LAS unsigned char* lds, const Gemm g, const Sched& S, const Epi& E, unsigned long long* stamps) {
    const int tid = otid(), wid = __builtin_amdgcn_readfirstlane(tid >> 6), lane = tid & 63, wr = wid >> 2, wc = wid & 3, fr = lane & 15, fq = lane >> 4;
    const int K = g.K, nt = K / BK;
    int ts_lo = 0, ts_hi = 0, nts = 0; const unsigned long long rt_entry = STAMP ? (unsigned long long)wall_clock64() : 0ull;
#define PG8_STAMP() do { if (STAMP && wid == 0 && nts < 64) { const unsigned long long _c = (unsigned long long)clock64(); \
        ts_lo = (lane == nts) ? (int)(unsigned)_c : ts_lo; ts_hi = (lane == nts) ? (int)(unsigned)(_c >> 32) : ts_hi; ++nts; } } while (0)
    PG8_STAMP();
    unsigned voffA[2], voffB[2];
#pragma unroll
    for (int i = 0; i < 2; ++i) { int R, C; stage_rc(tid * 16 + i * 8192, R, C); const int Rb = Epi::PERM ? ((R & ~31) + perm32(R & 31)) : R;
        voffA[i] = (unsigned)(R * K + C) * 2u; voffB[i] = (unsigned)(Rb * BK + C) * 2u; }
    const size_t kstep = (size_t)(BK * 2);
    const size_t hstep = (size_t)HALF * K * 2;
    const size_t tstep = 2 * hstep;
    const size_t kstepB = (size_t)BM * BK * 2, hstepB = (size_t)HALF * BK * 2, tstepB = (size_t)(K / BK) * kstepB;
    const unsigned ldsw = (unsigned)wid * 1024u;
    const int aoff = lds_byte(wr * 64 + fr, fq * 8), boff = lds_byte(wc * 32 + fr, fq * 8);
#define PG8_SA(b, h) (((b) * 2 + (h)) * HTB)
#define PG8_SB(b, h) ((4 + (b) * 2 + (h)) * HTB)
#define PG8_STAGE(bufoff, gbase, voff) do { _Pragma("unroll") for (int _i = 0; _i < 2; ++_i) \
        __builtin_amdgcn_global_load_lds((const unsigned*)((const char*)(gbase) + (voff)[_i]), (PG8_LAS unsigned*)(lds + (bufoff) + ldsw + _i * 8192), 16, 0, 0); } while (0)
#define PG8_LDA(dst, b, h) do { _Pragma("unroll") for (int m = 0; m < 4; ++m) _Pragma("unroll") for (int k = 0; k < 2; ++k) dst[m][k] = *(const PG8_LAS bf16x8*)(lds + PG8_SA(b, h) + aoff + m * 2048 + k * 1024); } while (0)
#define PG8_LDB(dst, b, h) do { _Pragma("unroll") for (int n = 0; n < 2; ++n) _Pragma("unroll") for (int k = 0; k < 2; ++k) dst[n][k] = *(const PG8_LAS bf16x8*)(lds + PG8_SB(b, h) + boff + n * 2048 + k * 1024); } while (0)
#define PG8_MMA(ai, bj, At, Bt) do { __builtin_amdgcn_s_setprio(1); _Pragma("unroll") for (int m = 0; m < 4; ++m) _Pragma("unroll") for (int n = 0; n < 2; ++n) _Pragma("unroll") for (int k = 0; k < 2; ++k) \
        acc[ai][bj][m][n] = __builtin_amdgcn_mfma_f32_16x16x32_bf16(Bt[n][k], At[m][k], acc[ai][bj][m][n], 0, 0, 0); __builtin_amdgcn_s_setprio(0); } while (0)
#define PG8_WAIT_V(n) asm volatile("s_waitcnt vmcnt(" #n ")" ::: "memory")
#define PG8_WAIT_L(n) asm volatile("s_waitcnt lgkmcnt(" #n ")" ::: "memory")
#define PG8_BAR __builtin_amdgcn_s_barrier()
#define PG8_SCHED __builtin_amdgcn_sched_barrier(0)
    Unit cur, nxt; int ui = 0;
    if (!S.next(0, cur)) return;
    f32x4 acc[2][2][4][2];
#pragma unroll
    for (int a = 0; a < 2; ++a)
#pragma unroll
        for (int b = 0; b < 2; ++b)
#pragma unroll
            for (int m = 0; m < 4; ++m)
#pragma unroll
                for (int n = 0; n < 2; ++n) acc[a][b][m][n] = (f32x4){0.f, 0.f, 0.f, 0.f};
    bf16x8 At[4][2], B0[2][2], B1[2][2];
    float epre[8];
#pragma unroll
    for (int i = 0; i < 8; ++i) epre[i] = 0.f;
    const char* cA = (const char*)g.A + (size_t)cur.pm * tstep; const char* cB = (const char*)g.Bt + (size_t)cur.pn * tstepB;
    S.a_ready(cur);
    PG8_STAGE(PG8_SB(0, 0), cB, voffB); PG8_STAGE(PG8_SA(0, 0), cA, voffA); PG8_STAGE(PG8_SB(0, 1), cB + hstepB, voffB); PG8_STAGE(PG8_SA(0, 1), cA + hstep, voffA);
    if (wr == 1) PG8_BAR;
    PG8_WAIT_V(4); PG8_BAR;
    PG8_STAGE(PG8_SB(1, 0), cB + kstepB, voffB); PG8_STAGE(PG8_SA(1, 0), cA + kstep, voffA); PG8_STAGE(PG8_SB(1, 1), cB + hstepB + kstepB, voffB);
    PG8_WAIT_V(6); PG8_BAR;
    PG8_STAMP();
    for (;;) {
        const bool has_next = S.next(ui + 1, nxt);
        const char* nA = has_next ? (const char*)g.A + (size_t)nxt.pm * tstep : cA; const char* nB = has_next ? (const char*)g.Bt + (size_t)nxt.pn * tstepB : cB;
        for (int t = 0; t < nt; t += 2) {
            const bool last = (t == nt - 2);
            const char* a1 = cA + (size_t)(t + 1) * kstep;
            const char* a2 = last ? nA : cA + (size_t)(t + 2) * kstep; const char* b2 = last ? nB : cB + (size_t)(t + 2) * kstepB;
            const char* a3 = a2 + kstep; const char* b3 = b2 + kstepB;
            if (last && has_next) S.a_ready(nxt);
            if (last) E.prefetch(cur, wr, wc, fr, fq, epre);
            PG8_LDB(B0, 0, 0); PG8_SCHED; PG8_LDA(At, 0, 0); PG8_STAGE(PG8_SA(1, 1), a1 + hstep, voffA);
            PG8_WAIT_L(8); PG8_BAR; PG8_WAIT_L(0); PG8_MMA(0, 0, At, B0); PG8_BAR; PG8_SCHED;
            PG8_LDB(B1, 0, 1); PG8_STAGE(PG8_SB(0, 0), b2, voffB);
            PG8_BAR; PG8_WAIT_L(0); PG8_MMA(0, 1, At, B1); PG8_BAR;
            PG8_LDA(At, 0, 1); PG8_STAGE(PG8_SA(0, 0), a2, voffA);
            PG8_BAR; PG8_WAIT_L(0); PG8_MMA(1, 0, At, B0); PG8_BAR; PG8_SCHED;
            PG8_STAGE(PG8_SB(0, 1), b2 + hstepB, voffB);
            PG8_WAIT_V(6); PG8_BAR; PG8_MMA(1, 1, At, B1); PG8_BAR;
            PG8_LDB(B0, 1, 0); PG8_SCHED; PG8_LDA(At, 1, 0); PG8_STAGE(PG8_SA(0, 1), a2 + hstep, voffA);
            PG8_WAIT_L(8); PG8_BAR; PG8_WAIT_L(0); PG8_MMA(0, 0, At, B0); PG8_BAR; PG8_SCHED;
            PG8_LDB(B1, 1, 1); PG8_STAGE(PG8_SB(1, 0), b3, voffB);
            PG8_BAR; PG8_WAIT_L(0); PG8_MMA(0, 1, At, B1); PG8_BAR;
            PG8_LDA(At, 1, 1); PG8_STAGE(PG8_SA(1, 0), a3, voffA);
            PG8_BAR; PG8_WAIT_L(0); PG8_MMA(1, 0, At, B0); PG8_BAR; PG8_SCHED;
            PG8_STAGE(PG8_SB(1, 1), b3 + hstepB, voffB);
            PG8_WAIT_V(6); PG8_BAR; PG8_MMA(1, 1, At, B1); PG8_BAR;
        }
        PG8_STAMP();
        if constexpr (!Epi::AFTER_DRAIN) { E(acc, cur, wr, wc, fr, fq, epre); S.done(cur); }
        PG8_STAMP();
        if (!has_next) break;
#pragma unroll
        for (int a = 0; a < 2; ++a)
#pragma unroll
            for (int b = 0; b < 2; ++b)
#pragma unroll
                for (int m = 0; m < 4; ++m)
#pragma unroll
                    for (int n = 0; n < 2; ++n) acc[a][b][m][n] = (f32x4){0.f, 0.f, 0.f, 0.f};
        cur = nxt; cA = nA; cB = nB; ++ui;
    }
    PG8_WAIT_V(0);
    if (wr == 0) PG8_BAR;
    PG8_BAR;
    if constexpr (Epi::AFTER_DRAIN) { E.fused(acc, cur, wr, wc, fr, fq, lds, wid, lane); S.done(cur); }
    PG8_STAMP();
    if (STAMP && wid == 0) { stamps[lane] = lane < nts ? (((unsigned long long)(unsigned)ts_hi << 32) | (unsigned)ts_lo) : 0ull;
        if (lane == 62) stamps[62] = rt_entry; if (lane == 63) stamps[63] = (unsigned long long)wall_clock64(); }
#undef PG8_STAMP
#undef PG8_SA
#undef PG8_SB
#undef PG8_STAGE
#undef PG8_LDA
#undef PG8_LDB
#undef PG8_MMA
#undef PG8_WAIT_V
#undef PG8_WAIT_L
#undef PG8_BAR
#undef PG8_SCHED
}
}

using pg8::bf16_t; using pg8::bf16x8; using pg8::f32x4; using pg8::u32x4; using pg8::Unit; using pg8::Gemm; using pg8::cvt_pk_bf16;
typedef unsigned u32x2 __attribute__((ext_vector_type(2)));
typedef short s16x4 __attribute__((ext_vector_type(4)));
#define LAS __attribute__((address_space(3)))

constexpr int MTOK = 65536, DM = 1024, DFF = 2816, NIN = 3080, NINP = 3328;
constexpr float EPS = 1e-6f;
constexpr size_t MiB = 1024ull * 1024ull;
constexpr size_t WS_XB = 0, WS_R1 = 128 * MiB, WS_DN = 512 * MiB, WS_MIX = 800 * MiB, WS_W = 928 * MiB;
constexpr size_t WS_BT1 = WS_W, WS_BT2 = WS_BT1 + 5632ull * 1024 * 2, WS_BT3 = WS_BT2 + 1024ull * 2816 * 2, WS_BT4 = WS_BT3 + 3328ull * 1024 * 2,
                 WS_BT5 = WS_BT4 + 1024ull * 1024 * 2, WS_BT6 = WS_BT5 + 5632ull * 1024 * 2, WS_WEND = WS_BT6 + 1024ull * 2816 * 2;
constexpr size_t WS_WC = 970 * MiB, WS_SSQ = 971 * MiB  , WS_BA = 987 * MiB  , WS_GL = 989 * MiB, WS_BAR = 989 * MiB + 65536  , WS_END = 990 * MiB;
static_assert(WS_WEND <= WS_WC, "weights overflow");
constexpr size_t WS_U = WS_R1, WS_V = WS_U + 64 * MiB, WS_QKV = WS_V + 64 * MiB, WS_Z = WS_QKV + 192 * MiB;

struct Params {
    const float* x; const float* ffn1_norm; const float* ffn1_wg; const float* ffn1_wu; const float* ffn1_wd; const float* mix_norm; const float* w_in; const float* conv_w;
    const float* a_log; const float* dt_bias; const float* dn_norm; const float* sg_ln_g; const float* sg_ln_b; const float* sg_w; const float* sg_b; const float* w_out;
    const float* ffn2_norm; const float* ffn2_wg; const float* ffn2_wu; const float* ffn2_wd; const float* final_norm;
    float* out; unsigned char* ws;
};

__device__ __forceinline__ unsigned short f2bf(float f) { unsigned u = __float_as_uint(f); u += 0x7fffu + ((u >> 16) & 1u); return (unsigned short)(u >> 16); }
__device__ __forceinline__ float bf2f(unsigned short b) { return __uint_as_float(((unsigned)b) << 16); }
__device__ __forceinline__ float bflo(unsigned w) { return __uint_as_float(w << 16); }
__device__ __forceinline__ float bfhi(unsigned w) { return __uint_as_float(w & 0xffff0000u); }
typedef __bf16 bf2_t __attribute__((ext_vector_type(2)));
typedef float f32x2 __attribute__((ext_vector_type(2)));
__device__ __forceinline__ unsigned pk(float a, float b) { f32x2 v = {a, b}; return __builtin_bit_cast(unsigned, __builtin_convertvector(v, bf2_t)); }
#define MFMA16(a, b, c) __builtin_amdgcn_mfma_f32_16x16x32_bf16((a), (b), (c), 0, 0, 0)
template <int CTRL> __device__ __forceinline__ float dpp_mov(float v) { return __builtin_bit_cast(float, __builtin_amdgcn_update_dpp(0, __builtin_bit_cast(int, v), CTRL, 0xf, 0xf, true)); }
__device__ __forceinline__ float wave_sum(float v) {
    v += dpp_mov<0xB1>(v);
    v += dpp_mov<0x4E>(v);
    v += dpp_mov<0x141>(v);
    v += dpp_mov<0x140>(v);
    const int iv = __builtin_bit_cast(int, v);
    const float a = __builtin_bit_cast(float, __builtin_amdgcn_readlane(iv, 0)), b = __builtin_bit_cast(float, __builtin_amdgcn_readlane(iv, 16));
    const float c = __builtin_bit_cast(float, __builtin_amdgcn_readlane(iv, 32)), d = __builtin_bit_cast(float, __builtin_amdgcn_readlane(iv, 48));
    return (a + b) + (c + d);
}
__device__ __forceinline__ float silu_f(float v) { return v * __builtin_amdgcn_rcpf(1.0f + __expf(-v)); }
__device__ __forceinline__ float gelu_tanh_f(float v) {
    const float u = 0.7978845608028654f * (v + 0.044715f * v * v * v);
    const float e = __expf(2.0f * u);
    const float t = 1.0f - 2.0f * __builtin_amdgcn_rcpf(e + 1.0f);
    return 0.5f * v * (1.0f + t);
}
__device__ __forceinline__ float rstd_of(const float* ssq, int row) { return __builtin_amdgcn_rsqf(ssq[row] * (1.0f / 1024.0f) + EPS); }

struct EpiGateUp {
    static constexpr bool PERM = true, AFTER_DRAIN = false;
    bf16_t* act; const float* ssq;
    __device__ __forceinline__ void prefetch(const Unit& u, int wr, int wc, int fr, int fq, float (&pre)[8]) const {
        const int row0 = u.pm * 256 + wr * 64 + fr;
#pragma unroll
        for (int i = 0; i < 8; ++i) pre[i] = ssq[row0 + (i >> 2) * 128 + (i & 3) * 16];
    }
    __device__ __forceinline__ void operator()(const f32x4 (&acc)[2][2][4][2], const Unit& u, int wr, int wc, int fr, int fq, const float (&pre)[8]) const {
        const int row0 = u.pm * 256 + wr * 64 + fr, col0 = u.pn * 128 + wc * 32 + 8 * fq;
#pragma unroll
        for (int ai = 0; ai < 2; ++ai)
#pragma unroll
            for (int m = 0; m < 4; ++m) {
                const int row = row0 + ai * 128 + m * 16;
                const float rs = __builtin_amdgcn_rsqf(pre[ai * 4 + m] * (1.0f / 1024.0f) + EPS);
                float o[8], gg[8], ee[8];
                const float nrs = rs * -1.4426950408889634f;
#pragma unroll
                for (int k = 0; k < 8; ++k) ee[k] = acc[ai][0][m][k >> 2][k & 3] * nrs;
#pragma unroll
                for (int k = 0; k < 8; ++k) { ee[k] = __builtin_amdgcn_exp2f(ee[k]); gg[k] = (acc[ai][0][m][k >> 2][k & 3] * rs) * (acc[ai][1][m][k >> 2][k & 3] * rs); }
#pragma unroll
                for (int k = 0; k < 8; ++k) ee[k] = 1.0f + ee[k];
#pragma unroll
                for (int k = 0; k < 8; ++k) ee[k] = __builtin_amdgcn_rcpf(ee[k]);
#pragma unroll
                for (int k = 0; k < 8; ++k) o[k] = gg[k] * ee[k];
                u32x4 w; w.x = pk(o[0], o[1]); w.y = pk(o[2], o[3]); w.z = pk(o[4], o[5]); w.w = pk(o[6], o[7]);
                *(u32x4*)(act + (size_t)row * DFF + col0) = w;
            }
    }
};
template <bool RESF32> struct EpiResid {
    static constexpr bool PERM = true, AFTER_DRAIN = false;
    const float* res; bf16_t* xb; float* ssq; float alpha;
    __device__ __forceinline__ void prefetch(const Unit&, int, int, int, int, float (&)[8]) const {}
    __device__ __forceinline__ void operator()(const f32x4 (&acc)[2][2][4][2], const Unit& u, int wr, int wc, int fr, int fq, const float (&)[8]) const {
        const int row0 = u.pm * 256 + wr * 64 + fr, col0 = u.pn * 256 + wc * 32 + 8 * fq;
        u32x4 rb[2][4][2]; f32x4 rf[RESF32 ? 16 : 1][2];
#pragma unroll
        for (int ai = 0; ai < 2; ++ai)
#pragma unroll
            for (int m = 0; m < 4; ++m)
#pragma unroll
                for (int bj = 0; bj < 2; ++bj) {
                    const size_t off = (size_t)(row0 + ai * 128 + m * 16) * DM + col0 + bj * 128;
                    if constexpr (RESF32) { rf[(ai * 4 + m) * 2 + bj][0] = *(const f32x4*)(res + off); rf[(ai * 4 + m) * 2 + bj][1] = *(const f32x4*)(res + off + 4); }
                    else rb[ai][m][bj] = *(const u32x4*)(xb + off);
                }
        asm volatile("" ::: "memory");
#pragma unroll
        for (int ai = 0; ai < 2; ++ai)
#pragma unroll
            for (int m = 0; m < 4; ++m) {
                const int row = row0 + ai * 128 + m * 16;
                float sq = 0.f;
#pragma unroll
                for (int bj = 0; bj < 2; ++bj) {
                    const size_t off = (size_t)row * DM + col0 + bj * 128;
                    f32x4 r0, r1;
                    if constexpr (RESF32) { r0 = rf[(ai * 4 + m) * 2 + bj][0]; r1 = rf[(ai * 4 + m) * 2 + bj][1]; }
                    else { const u32x4 q = rb[ai][m][bj]; r0 = (f32x4){bflo(q.x), bfhi(q.x), bflo(q.y), bfhi(q.y)}; r1 = (f32x4){bflo(q.z), bfhi(q.z), bflo(q.w), bfhi(q.w)}; }
                    const f32x4 v0 = r0 + acc[ai][bj][m][0] * alpha, v1 = r1 + acc[ai][bj][m][1] * alpha;
                    sq += v0[0] * v0[0] + v0[1] * v0[1] + v0[2] * v0[2] + v0[3] * v0[3] + v1[0] * v1[0] + v1[1] * v1[1] + v1[2] * v1[2] + v1[3] * v1[3];
                    u32x4 w; w.x = pk(v0[0], v0[1]); w.y = pk(v0[2], v0[3]); w.z = pk(v1[0], v1[1]); w.w = pk(v1[2], v1[3]);
                    *(u32x4*)(xb + off) = w;
                }
                sq += __shfl_xor(sq, 16, 64); sq += __shfl_xor(sq, 32, 64);
                if (fq == 0) unsafeAtomicAdd(ssq + row, sq);
            }
    }
};

struct EpiInProj {
    static constexpr bool PERM = true, AFTER_DRAIN = false;
    unsigned char* ws; const float* ssq; const float* a_log; const float* dt_bias;
    __device__ __forceinline__ void prefetch(const Unit& u, int wr, int wc, int fr, int fq, float (&pre)[8]) const {
        const int row0 = u.pm * 256 + wr * 64 + fr;
#pragma unroll
        for (int i = 0; i < 8; ++i) pre[i] = ssq[row0 + (i >> 2) * 128 + (i & 3) * 16];
    }
    __device__ __forceinline__ void operator()(const f32x4 (&acc)[2][2][4][2], const Unit& u, int wr, int wc, int fr, int fq, const float (&pre)[8]) const {
        const int row0 = u.pm * 256 + wr * 64 + fr, pn = u.pn;
        if (pn < 12) {
            bf16_t* base; int ld, colt, mode;
            if (pn < 2) { base = (bf16_t*)(ws + WS_U); ld = 512; colt = pn * 256; mode = 1; }
            else if (pn < 4) { base = (bf16_t*)(ws + WS_V); ld = 512; colt = (pn - 2) * 256; mode = 1; }
            else if (pn < 10) { base = (bf16_t*)(ws + WS_QKV); ld = 1536; colt = (pn - 4) * 256; mode = 0; }
            else { base = (bf16_t*)(ws + WS_Z); ld = 512; colt = (pn - 10) * 256; mode = 2; }
            const int col0 = colt + wc * 32 + 8 * fq;
#pragma unroll
            for (int ai = 0; ai < 2; ++ai)
#pragma unroll
                for (int m = 0; m < 4; ++m) {
                    const int row = row0 + ai * 128 + m * 16;
                    const float rs = __builtin_amdgcn_rsqf(pre[ai * 4 + m] * (1.0f / 1024.0f) + EPS);
#pragma unroll
                    for (int bj = 0; bj < 2; ++bj) {
                        float o[8];
#pragma unroll
                        for (int k = 0; k < 8; ++k) o[k] = acc[ai][bj][m][k >> 2][k & 3] * rs;
                        if (mode != 0) {
                            float ee[8];
#pragma unroll
                            for (int k = 0; k < 8; ++k) { const float v = o[k]; const float a = (mode == 1) ? 1.5957691216057308f * (v + 0.044715f * v * v * v) : v; ee[k] = a * -1.4426950408889634f; }
#pragma unroll
                            for (int k = 0; k < 8; ++k) ee[k] = __builtin_amdgcn_exp2f(ee[k]);
#pragma unroll
                            for (int k = 0; k < 8; ++k) ee[k] = 1.0f + ee[k];
#pragma unroll
                            for (int k = 0; k < 8; ++k) ee[k] = __builtin_amdgcn_rcpf(ee[k]);
#pragma unroll
                            for (int k = 0; k < 8; ++k) o[k] = o[k] * ee[k];
                        }
                        u32x4 w; w.x = pk(o[0], o[1]); w.y = pk(o[2], o[3]); w.z = pk(o[4], o[5]); w.w = pk(o[6], o[7]);
                        *(u32x4*)(base + (size_t)row * ld + col0 + bj * 128) = w;
                    }
                }
        } else if (wc == 0 && fq == 0) {
            float* BA = (float*)(ws + WS_BA);
            const f32x4 al = *(const f32x4*)a_log, db = *(const f32x4*)dt_bias;
#pragma unroll
            for (int ai = 0; ai < 2; ++ai)
#pragma unroll
                for (int m = 0; m < 4; ++m) {
                    const int row = row0 + ai * 128 + m * 16;
                    const float rs = __builtin_amdgcn_rsqf(pre[ai * 4 + m] * (1.0f / 1024.0f) + EPS);
                    f32x4 be, gg;
#pragma unroll
                    for (int j = 0; j < 4; ++j) {
                        const float bv = acc[ai][0][m][0][j] * rs, av = acc[ai][0][m][1][j] * rs + db[j];
                        be[j] = 1.0f / (1.0f + __expf(-bv));
                        const float sp = fmaxf(av, 0.f) + log1pf(__expf(-fabsf(av)));
                        gg[j] = -__expf(al[j]) * sp;
                    }
                    *(f32x4*)(BA + (size_t)row * 8) = be; *(f32x4*)(BA + (size_t)row * 8 + 4) = gg;
                }
        }
    }
};

#ifndef DNP_S1
#define DNP_S1 1
#endif
#ifndef DNP_S3
#define DNP_S3 1
#endif
#ifndef DNP_S4
#define DNP_S4 1
#endif
#ifndef DNP_S5
#define DNP_S5 1
#endif
constexpr int KS = 136;
constexpr int DN_ITEM = 36864;
constexpr int SLOT_BYTES = 69376;

template <int I, int HALF> __device__ __forceinline__ void sol_load_row(f32x4 (&l)[16], const float* Lm, float dep) {
    constexpr int SPLIT = 5, NJ = (I + 3) / 4, LO = HALF ? SPLIT : 0, HI = HALF ? NJ : (NJ < SPLIT ? NJ : SPLIT);
    if constexpr (LO < HI) {
        int z; asm volatile("v_and_b32 %0, 0, %1" : "=v"(z) : "v"(dep));
        const f32x4* Lr = (const f32x4*)(Lm + I * 64 + z);
#pragma unroll
        for (int j4 = LO; j4 < HI; ++j4) l[j4] = Lr[j4];
    }
}
template <int I> __device__ __forceinline__ float sol_fma_row(const f32x4 (&l)[16], const float (&x)[64], float rhs) {
    float r0 = rhs, r1 = 0.f;
#pragma unroll
    for (int j4 = 0; j4 * 4 < I; ++j4) {
#pragma unroll
        for (int e = 0; e < 4; ++e) if (j4 * 4 + e < I) { if (j4 & 1) r1 -= l[j4][e] * x[j4 * 4 + e]; else r0 -= l[j4][e] * x[j4 * 4 + e]; }
    }
    return r0 + r1;
}
template <int I> struct SolRows {
    static __device__ __forceinline__ void run(f32x4 (&la)[16], f32x4 (&lb)[16], float (&x)[64], const float* Lm, const bf16_t* srcb, const float* scl, float rhs) {
        sol_load_row<I, 1>(la, Lm, I > 0 ? x[I - 1] : 0.f);
        float rhs_next = 0.f;
        if constexpr (I + 1 < 64) {
            sol_load_row<I + 1, 0>(lb, Lm, I > 0 ? x[I - 1] : 0.f);
            int z; asm volatile("v_and_b32 %0, 0, %1" : "=v"(z) : "v"(I > 0 ? x[I - 1] : 0.f));
            rhs_next = bf2f(srcb[(I + 1) * 136 + z]) * scl[I + 1 + z];
        }
        x[I] = sol_fma_row<I>(la, x, rhs);
        if constexpr (I + 1 < 64) SolRows<I + 1>::run(lb, la, x, Lm, srcb, scl, rhs_next);
    }
};
#define DNP_LANE_VARS \
    const int tid = otid(), slot = tid >> 8, ts = tid & 255, sw = ts >> 6, lane = tid & 63, fr = lane & 15, fq = lane >> 4; \
    unsigned char* sb = shm + slot * SLOT_BYTES; \
    bf16_t* kb = (bf16_t*)sb; bf16_t* qb = (bf16_t*)(sb + 17408); bf16_t* vb = (bf16_t*)(sb + 34816); \
    float* Lm = (float*)(sb + 52224); float* gcs = (float*)(sb + 68608); float* bts = (float*)(sb + 68864); float* bes = (float*)(sb + 69120); \
    (void)ts; (void)sw; (void)lane; (void)fr; (void)fq; (void)kb; (void)qb; (void)vb; (void)Lm; (void)gcs; (void)bts; (void)bes;
__device__ __forceinline__ void phase_dnpre(const Params& p, unsigned char* shm) {
    unsigned char* ws = p.ws;
    const int slot0 = otid() >> 8;
    const bf16_t* QKV = (const bf16_t*)(ws + WS_QKV); const float* BA = (const float*)(ws + WS_BA);
    bf16_t* DN = (bf16_t*)(ws + WS_DN); float* GL = (float*)(ws + WS_GL);
    unsigned xr[16][3], xmr[3][3]; float ba_b = 0.f, ba_g = 0.f;
    auto dnp_issue = [&](int it0n) {
        DNP_LANE_VARS
        const int itemn = it0n + slot0, bhn = itemn >> 5, nn = itemn & 31, bn = bhn >> 2, hn = bhn & 3;
        const int row0n = bn * 2048 + nn * 64, cq = hn * 128 + 2 * lane, tt0 = sw * 16;
#pragma unroll
        for (int i = 0; i < 16; ++i)
#pragma unroll
            for (int s2 = 0; s2 < 3; ++s2) xr[i][s2] = *(const unsigned*)(QKV + (size_t)(row0n + tt0 + i) * 1536 + s2 * 512 + cq);
#pragma unroll
        for (int r = 0; r < 3; ++r) {
            const int pos = nn * 64 + tt0 - 3 + r;
#pragma unroll
            for (int s2 = 0; s2 < 3; ++s2) { xmr[r][s2] = 0u; if (pos >= 0) xmr[r][s2] = *(const unsigned*)(QKV + (size_t)(bn * 2048 + pos) * 1536 + s2 * 512 + cq); }
        }
        if (sw == 0) { ba_b = BA[(size_t)(row0n + lane) * 8 + hn]; ba_g = BA[(size_t)(row0n + lane) * 8 + 4 + hn]; }
    };
    dnp_issue(blockIdx.x * 2);
    for (int it0 = blockIdx.x * 2; it0 < 4096; it0 += gridDim.x * 2) {
        const int item = it0 + slot0, bh = item >> 5, n = item & 31, b = bh >> 2, h = bh & 3;
        const int row0 = b * 2048 + n * 64;
        bf16_t* Dg = DN + (size_t)item * DN_ITEM; bf16_t* Wg = Dg; bf16_t* Qdg = Dg + 8192; bf16_t* KdTg = Dg + 16384; bf16_t* UTg = Dg + 24576; bf16_t* QKg = Dg + 32768;
        (void)row0; (void)n; (void)b;
        float cur_b, cur_g;
#if DNP_S1
        {
            DNP_LANE_VARS
            const int cq = h * 128 + 2 * lane;
            float w[4][6];
#pragma unroll
            for (int j = 0; j < 4; ++j)
#pragma unroll
                for (int s = 0; s < 3; ++s) { const f32x2 t = *(const f32x2*)(p.conv_w + j * 1536 + s * 512 + cq); w[j][2 * s] = t.x; w[j][2 * s + 1] = t.y; }
            float xm[3][6];
            const int tt0 = sw * 16;
#pragma unroll
            for (int r = 0; r < 3; ++r)
#pragma unroll
                for (int s = 0; s < 3; ++s) { xm[r][2 * s] = bflo(xmr[r][s]); xm[r][2 * s + 1] = bfhi(xmr[r][s]); }
            cur_b = ba_b; cur_g = ba_g;
#pragma unroll
            for (int i = 0; i < 16; ++i) {
                float x0[6], y[6];
#pragma unroll
                for (int s = 0; s < 3; ++s) { const unsigned v = xr[i][s]; x0[2 * s] = bflo(v); x0[2 * s + 1] = bfhi(v); }
#pragma unroll
                for (int c = 0; c < 6; ++c) { const float t = w[0][c] * xm[0][c] + w[1][c] * xm[1][c] + w[2][c] * xm[2][c] + w[3][c] * x0[c]; y[c] = silu_f(t); }
                const float sq = wave_sum(y[0] * y[0] + y[1] * y[1]), sk = wave_sum(y[2] * y[2] + y[3] * y[3]);
                const float rq = __builtin_amdgcn_rsqf(sq + EPS) * 0.08838834764831845f, rk = __builtin_amdgcn_rsqf(sk + EPS);
                *(unsigned*)(qb + (tt0 + i) * KS + 2 * lane) = pk(y[0] * rq, y[1] * rq);
                *(unsigned*)(kb + (tt0 + i) * KS + 2 * lane) = pk(y[2] * rk, y[3] * rk);
                *(unsigned*)(vb + (tt0 + i) * KS + 2 * lane) = pk(y[4], y[5]);
#pragma unroll
                for (int c = 0; c < 6; ++c) { xm[0][c] = xm[1][c]; xm[1][c] = xm[2][c]; xm[2][c] = x0[c]; }
            }
        }
        asm volatile("" ::: "memory");
        if (it0 + (int)gridDim.x * 2 < 4096) dnp_issue(it0 + (int)gridDim.x * 2);
        asm volatile("" ::: "memory");
#endif
        { DNP_LANE_VARS
        if (sw == 0) {
            const float beta = cur_b; float g = cur_g;
#pragma unroll
            for (int o = 1; o < 64; o <<= 1) { const float t = __shfl_up(g, o, 64); if (lane >= o) g += t; }
            gcs[lane] = g; bts[lane] = beta; bes[lane] = beta * __expf(g);
        } }
        __syncthreads();
#if DNP_S3
        {
            DNP_LANE_VARS
            bf16x8 ak[4], aq[4];
#pragma unroll
            for (int kk = 0; kk < 4; ++kk) { ak[kk] = *(const bf16x8*)(kb + (16 * sw + fr) * KS + 32 * kk + 8 * fq); aq[kk] = *(const bf16x8*)(qb + (16 * sw + fr) * KS + 32 * kk + 8 * fq); }
            float gci[4], bi[4];
#pragma unroll
            for (int r = 0; r < 4; ++r) { gci[r] = gcs[16 * sw + 4 * fq + r]; bi[r] = bts[16 * sw + 4 * fq + r]; }
#pragma unroll
            for (int jt = 0; jt < 4; ++jt) {
                if (jt <= sw) {
                    f32x4 dk = {0.f, 0.f, 0.f, 0.f}, dq = {0.f, 0.f, 0.f, 0.f};
#pragma unroll
                    for (int kk = 0; kk < 4; ++kk) { const bf16x8 bb = *(const bf16x8*)(kb + (16 * jt + fr) * KS + 32 * kk + 8 * fq); dk = MFMA16(ak[kk], bb, dk); dq = MFMA16(aq[kk], bb, dq); }
                    const int j = 16 * jt + fr; const float gcj = gcs[j];
#pragma unroll
                    for (int r = 0; r < 4; ++r) {
                        const int i = 16 * sw + 4 * fq + r; const float dec = __expf(gci[r] - gcj);
                        Lm[((i >> 1) * 64 + j) * 2 + (i & 1)] = (i > j) ? bi[r] * dk[r] * dec : 0.f;
                        const float qv = (i >= j) ? dq[r] * dec : 0.f;
                        QKg[i * 64 + j] = (bf16_t)(pk(qv, 0.f) & 0xffffu);
                    }
                } else {
#pragma unroll
                    for (int r = 0; r < 4; ++r) QKg[(16 * sw + 4 * fq + r) * 64 + 16 * jt + fr] = (bf16_t)0;
                }
            }
        }
#endif
        __syncthreads();
#if DNP_S5
        {
            DNP_LANE_VARS
            const float gl_last = gcs[63];
#pragma unroll
            for (int rep = 0; rep < 4; ++rep) {
                const int chunk = ts + 256 * rep, i = chunk >> 4, d0 = (chunk & 15) * 8;
                const u32x4 v = *(const u32x4*)(qb + i * KS + d0); const float s = __expf(gcs[i]);
                u32x4 w; w.x = pk(bflo(v.x) * s, bfhi(v.x) * s); w.y = pk(bflo(v.y) * s, bfhi(v.y) * s); w.z = pk(bflo(v.z) * s, bfhi(v.z) * s); w.w = pk(bflo(v.w) * s, bfhi(v.w) * s);
                *(u32x4*)(Qdg + i * 128 + d0) = w;
            }
            const int d = ts & 127, half = ts >> 7;
#pragma unroll
            for (int i8 = 0; i8 < 4; ++i8) {
                float o[8];
#pragma unroll
                for (int e = 0; e < 8; ++e) { const int i = 32 * half + 8 * i8 + e; o[e] = bf2f(kb[i * KS + d]) * __expf(gl_last - gcs[i]); }
                u32x4 w; w.x = pk(o[0], o[1]); w.y = pk(o[2], o[3]); w.z = pk(o[4], o[5]); w.w = pk(o[6], o[7]);
                *(u32x4*)(KdTg + d * 64 + 32 * half + 8 * i8) = w;
            }
            if (ts == 0) GL[item] = __expf(gl_last);
        }
#endif
#if DNP_S4
        {
            DNP_LANE_VARS
            const bool isU = ts < 128; const bf16_t* srcb = isU ? vb : kb; const float* scl = isU ? bts : bes; const int cc = ts & 127;
            float x[64];
            {
                const bf16_t* sc = srcb + cc;
                f32x4 lb[2][4], lt[2][3]; float rh[2][4];
                int zt = 0, k = 0;
                auto opaque0 = [](float v) { int z; asm volatile("v_and_b32 %0, 0, %1" : "=v"(z) : "v"(v)); return z; };
                auto fnma2 = [](f32x2 l, float xv, f32x2 a) { return __builtin_elementwise_fma(-l, (f32x2){xv, xv}, a); };
                auto ld_group = [&](int pp, int c, int slot, int z) {
                    const float* a = Lm + ((2 * pp) * 64 + 4 * c) * 2 + z; const float* b = Lm + ((2 * pp + 1) * 64 + 4 * c) * 2 + z;
                    lb[slot][0] = *(const f32x4*)a; lb[slot][1] = *(const f32x4*)(a + 4); lb[slot][2] = *(const f32x4*)b; lb[slot][3] = *(const f32x4*)(b + 4);
                };
                auto ld_misc = [&](int pp, int z) {
                    lt[pp & 1][0] = *(const f32x4*)(Lm + ((2 * pp) * 64 + 4 * pp) * 2 + z);
                    lt[pp & 1][1] = *(const f32x4*)(Lm + ((2 * pp + 1) * 64 + 4 * pp) * 2 + z);
                    lt[pp & 1][2] = *(const f32x4*)(Lm + ((2 * pp + 1) * 64 + 4 * pp) * 2 + 4 + z);
                    const f32x4 s4 = *(const f32x4*)(scl + 4 * pp + z);
#pragma unroll
                    for (int r = 0; r < 4; ++r) rh[pp & 1][r] = bf2f(sc[(4 * pp + r) * KS + z]) * s4[r];
                };
                ld_misc(0, 0);
                ld_group(1, 0, 0, 0);
#pragma unroll
                for (int pp = 0; pp < 16; ++pp) {
                    f32x2 accA = {rh[pp & 1][0], rh[pp & 1][1]}, accB = {rh[pp & 1][2], rh[pp & 1][3]};
                    if (pp + 1 < 16) ld_misc(pp + 1, zt);
#pragma unroll
                    for (int c = 0; c < pp; ++c) {
                        const int np = (c + 1 < pp) ? pp : pp + 1, nc = (c + 1 < pp) ? c + 1 : 0;
                        if (np < 16) ld_group(np, nc, (k + 1) & 1, zt);
                        const f32x4 l0 = lb[k & 1][0], l1 = lb[k & 1][1], l2 = lb[k & 1][2], l3 = lb[k & 1][3];
                        accA = fnma2((f32x2){l0[0], l0[1]}, x[4 * c], accA); accB = fnma2((f32x2){l2[0], l2[1]}, x[4 * c], accB);
                        accA = fnma2((f32x2){l0[2], l0[3]}, x[4 * c + 1], accA); accB = fnma2((f32x2){l2[2], l2[3]}, x[4 * c + 1], accB);
                        accA = fnma2((f32x2){l1[0], l1[1]}, x[4 * c + 2], accA); accB = fnma2((f32x2){l3[0], l3[1]}, x[4 * c + 2], accB);
                        accA = fnma2((f32x2){l1[2], l1[3]}, x[4 * c + 3], accA); accB = fnma2((f32x2){l3[2], l3[3]}, x[4 * c + 3], accB);
                        zt = opaque0(accA[0]);
                        ++k;
                    }
                    const f32x4 tA = lt[pp & 1][0], tB0 = lt[pp & 1][1], tB1 = lt[pp & 1][2];
                    const float x0 = accA[0], x1 = accA[1] - tA[1] * x0;
                    accB = fnma2((f32x2){tB0[0], tB0[1]}, x0, accB); accB = fnma2((f32x2){tB0[2], tB0[3]}, x1, accB);
                    const float x2 = accB[0], x3 = accB[1] - tB1[1] * x2;
                    x[4 * pp] = x0; x[4 * pp + 1] = x1; x[4 * pp + 2] = x2; x[4 * pp + 3] = x3;
                }
            }
            if (isU) {
#pragma unroll
                for (int i8 = 0; i8 < 8; ++i8) { u32x4 w; w.x = pk(x[8 * i8], x[8 * i8 + 1]); w.y = pk(x[8 * i8 + 2], x[8 * i8 + 3]); w.z = pk(x[8 * i8 + 4], x[8 * i8 + 5]); w.w = pk(x[8 * i8 + 6], x[8 * i8 + 7]);
                    *(u32x4*)(UTg + cc * 64 + 8 * i8) = w; }
            } else {
#pragma unroll
                for (int i = 0; i < 64; ++i) Wg[i * 128 + cc] = (bf16_t)(pk(x[i], 0.f) & 0xffffu);
            }
        }
#endif
        __syncthreads();
    }
}

__device__ __forceinline__ bf16x8 ldfrag_perm(const bf16_t* rp, int fq) {
    const u32x2 lo = *(const u32x2*)(rp + 4 * fq), hi = *(const u32x2*)(rp + 16 + 4 * fq);
    u32x4 w; w.x = lo.x; w.y = lo.y; w.z = hi.x; w.w = hi.y; return __builtin_bit_cast(bf16x8, w);
}
__device__ __forceinline__ bf16x8 pack2(const f32x4 a, const f32x4 b) { u32x4 w; w.x = pk(a[0], a[1]); w.y = pk(a[2], a[3]); w.z = pk(b[0], b[1]); w.w = pk(b[2], b[3]); return __builtin_bit_cast(bf16x8, w); }
__device__ __forceinline__ bf16x8 ldfrag_lds(const unsigned char* rp, int fq) {
    return *(const bf16x8*)(rp + 16 * fq);
}
constexpr int SC_W = 0, SC_QD = 17408, SC_KDT = 34816, SC_QK = 55296, SC_BUF = 64512, SC_OB = 2 * SC_BUF, ST_W = 272, ST_K = 160, ST_Q = 144, OBS = 128;
__device__ __forceinline__ void scan_bh(const Params& p, unsigned char* shm, int bh) {
    unsigned char* ws = p.ws;
    const int tid = otid(), wid = tid >> 6, lane = tid & 63, fr = lane & 15, fq = lane >> 4;
    const int b = bh >> 2, h = bh & 3, e0 = wid * 16;
    float* ob = (float*)(shm + SC_OB);
    const bf16_t* DN = (const bf16_t*)(ws + WS_DN); const float* GL = (const float*)(ws + WS_GL); const bf16_t* Zb = (const bf16_t*)(ws + WS_Z); bf16_t* MIX = (bf16_t*)(ws + WS_MIX);
    const int ec = tid >> 3, ee = (tid & 7) * 16;
    f32x4 dnw[4];
#pragma unroll
    for (int i = 0; i < 4; ++i) dnw[i] = *(const f32x4*)(p.dn_norm + ee + 4 * i);
    int soff[7], goff[7];
    auto pieceoff = [](int m) { return (m < 2) ? 32 * m : 32 * (m - 2) + 8; };
#pragma unroll
    for (int i = 0; i < 4; ++i) { const int chunk = tid + 512 * i, c1 = chunk & 1023, c16 = c1 & 15; goff[i] = chunk * 8; soff[i] = (i < 2 ? SC_W : SC_QD) + (c1 >> 4) * ST_W + (c16 >> 2) * 64 + pieceoff(c16 & 3); }
#pragma unroll
    for (int i = 4; i < 6; ++i) { const int c1 = tid + 512 * (i - 4), c8 = c1 & 7; goff[i] = 16384 + c1 * 8; soff[i] = SC_KDT + (c1 >> 3) * ST_K + (c8 >> 2) * 64 + pieceoff(c8 & 3); }
    { const int c8 = tid & 7; goff[6] = 32768 + tid * 8; soff[6] = SC_QK + (tid >> 3) * ST_Q + (c8 >> 2) * 64 + pieceoff(c8 & 3); }
    f32x4 S[8];
#pragma unroll
    for (int i = 0; i < 8; ++i) S[i] = (f32x4){0.f, 0.f, 0.f, 0.f};
    u32x4 st[7]; u32x2 ut[4]; float gl;
    {
        const bf16_t* Dg = DN + (size_t)(bh * 32) * DN_ITEM;
#pragma unroll
        for (int i = 0; i < 7; ++i) st[i] = *(const u32x4*)(Dg + goff[i]);
#pragma unroll
        for (int ct = 0; ct < 4; ++ct) ut[ct] = *(const u32x2*)(Dg + 24576 + (e0 + fr) * 64 + 16 * ct + 4 * fq);
        gl = GL[bh * 32];
#pragma unroll
        for (int i = 0; i < 7; ++i) { *(u32x2*)(shm + soff[i]) = (u32x2){st[i].x, st[i].y}; *(u32x2*)(shm + soff[i] + 16) = (u32x2){st[i].z, st[i].w}; }
        const bf16_t* D1 = DN + (size_t)(bh * 32 + 1) * DN_ITEM;
#pragma unroll
        for (int i = 0; i < 7; ++i) st[i] = *(const u32x4*)(D1 + goff[i]);
    }
    __syncthreads();
    u32x4 zn0, zn1;
    { const size_t r0z = (size_t)b * 2048 + ec; zn0 = *(const u32x4*)(Zb + r0z * 512 + h * 128 + ee); zn1 = *(const u32x4*)(Zb + r0z * 512 + h * 128 + ee + 8); }
    auto scan_epi = [&](int nn, const u32x4 z0, const u32x4 z1) {
        {
            const size_t row = (size_t)b * 2048 + nn * 64 + ec;
            f32x4 o4[4]; float ss = 0.f;
#pragma unroll
            for (int i = 0; i < 4; ++i) { o4[i] = *(const f32x4*)(ob + ec * OBS + ee + 4 * i); ss += o4[i][0] * o4[i][0] + o4[i][1] * o4[i][1] + o4[i][2] * o4[i][2] + o4[i][3] * o4[i][3]; }
            ss += __shfl_xor(ss, 1, 64); ss += __shfl_xor(ss, 2, 64); ss += __shfl_xor(ss, 4, 64);
            const float rs = __builtin_amdgcn_rsqf(ss * (1.0f / 128.0f) + EPS);
            const unsigned zz[8] = {z0.x, z0.y, z0.z, z0.w, z1.x, z1.y, z1.z, z1.w};
            unsigned ow[8];
#pragma unroll
            for (int i = 0; i < 4; ++i) {
                const f32x4 v = o4[i] * rs * dnw[i];
                ow[2 * i] = pk(v[0] * bflo(zz[2 * i]), v[1] * bfhi(zz[2 * i])); ow[2 * i + 1] = pk(v[2] * bflo(zz[2 * i + 1]), v[3] * bfhi(zz[2 * i + 1]));
            }
            u32x4 w0, w1; w0.x = ow[0]; w0.y = ow[1]; w0.z = ow[2]; w0.w = ow[3]; w1.x = ow[4]; w1.y = ow[5]; w1.z = ow[6]; w1.w = ow[7];
            *(u32x4*)(MIX + row * 1024 + 512 + h * 128 + ee) = w0; *(u32x4*)(MIX + row * 1024 + 512 + h * 128 + ee + 8) = w1;
        }
    };
    u32x4 zq0 = {0u, 0u, 0u, 0u}, zq1 = {0u, 0u, 0u, 0u};
    for (int n = 0; n < 32; ++n) {
        const unsigned char* buf = shm + (n & 1) * SC_BUF;
        u32x2 utc[4]; const float glc = gl;
#pragma unroll
        for (int ct = 0; ct < 4; ++ct) utc[ct] = ut[ct];
        const size_t row = (size_t)b * 2048 + n * 64 + ec;
        if (n > 0) scan_epi(n - 1, zq0, zq1);
        if (n + 1 < 32) {
            const bf16_t* Dg = DN + (size_t)(bh * 32 + n + 1) * DN_ITEM;
#pragma unroll
            for (int ct = 0; ct < 4; ++ct) ut[ct] = *(const u32x2*)(Dg + 24576 + (e0 + fr) * 64 + 16 * ct + 4 * fq);
            gl = GL[bh * 32 + n + 1];
        }
        bf16x8 SB[4];
#pragma unroll
        for (int kb = 0; kb < 4; ++kb) SB[kb] = pack2(S[2 * kb], S[2 * kb + 1]);
        f32x4 Vn[4], O[4];
#pragma unroll
        for (int ct = 0; ct < 4; ++ct) {
            f32x4 P = {0.f, 0.f, 0.f, 0.f}, Oq = {0.f, 0.f, 0.f, 0.f};
            const unsigned char* wrp = buf + SC_W + (16 * ct + fr) * ST_W; const unsigned char* qrp = buf + SC_QD + (16 * ct + fr) * ST_W;
#pragma unroll
            for (int kb = 0; kb < 4; ++kb) { P = MFMA16(ldfrag_lds(wrp + 64 * kb, fq), SB[kb], P); Oq = MFMA16(ldfrag_lds(qrp + 64 * kb, fq), SB[kb], Oq); }
            const u32x2 uu = utc[ct];
            Vn[ct] = (f32x4){bflo(uu.x) - P[0], bfhi(uu.x) - P[1], bflo(uu.y) - P[2], bfhi(uu.y) - P[3]}; O[ct] = Oq;
        }
        bf16x8 VB[2]; VB[0] = pack2(Vn[0], Vn[1]); VB[1] = pack2(Vn[2], Vn[3]);
#pragma unroll
        for (int ct = 0; ct < 4; ++ct)
#pragma unroll
            for (int kc = 0; kc < 2; ++kc) O[ct] = MFMA16(ldfrag_lds(buf + SC_QK + (16 * ct + fr) * ST_Q + 64 * kc, fq), VB[kc], O[ct]);
#pragma unroll
        for (int dt = 0; dt < 8; ++dt) {
            f32x4 a = S[dt] * glc;
#pragma unroll
            for (int kc = 0; kc < 2; ++kc) a = MFMA16(ldfrag_lds(buf + SC_KDT + (16 * dt + fr) * ST_K + 64 * kc, fq), VB[kc], a);
            S[dt] = a;
        }
        __syncthreads();
#pragma unroll
        for (int ct = 0; ct < 4; ++ct)
#pragma unroll
            for (int r = 0; r < 4; ++r) ob[(16 * ct + 4 * fq + r) * OBS + e0 + fr] = O[ct][r];
        if (n + 1 < 32) {
            unsigned char* nb = shm + ((n + 1) & 1) * SC_BUF;
#pragma unroll
            for (int i = 0; i < 7; ++i) { *(u32x2*)(nb + soff[i]) = (u32x2){st[i].x, st[i].y}; *(u32x2*)(nb + soff[i] + 16) = (u32x2){st[i].z, st[i].w}; }
        }
        if (n + 2 < 32) {
            const bf16_t* D2 = DN + (size_t)(bh * 32 + n + 2) * DN_ITEM;
#pragma unroll
            for (int i = 0; i < 7; ++i) st[i] = *(const u32x4*)(D2 + goff[i]);
        }
        __syncthreads();
        zq0 = zn0; zq1 = zn1;
        if (n + 1 < 32) { const size_t rz = (size_t)b * 2048 + (n + 1) * 64 + ec; zn0 = *(const u32x4*)(Zb + rz * 512 + h * 128 + ee); zn1 = *(const u32x4*)(Zb + rz * 512 + h * 128 + ee + 8); }
    }
    scan_epi(31, zq0, zq1);
}

__device__ __forceinline__ void sg_item(const Params& p, unsigned char* shm, int item) {
    unsigned char* ws = p.ws;
    const int tid = otid(), wid = tid >> 6, lane = tid & 63, fr = lane & 15, fq = lane >> 4;
    const int r0 = item * 128;
    bf16_t* vT = (bf16_t*)shm;
    const bf16_t* Vg = (const bf16_t*)(ws + WS_V); const bf16_t* Ug = (const bf16_t*)(ws + WS_U); const bf16_t* Wc = (const bf16_t*)(ws + WS_WC); bf16_t* MIX = (bf16_t*)(ws + WS_MIX);
    float lg[8], lb[8];
#pragma unroll
    for (int j = 0; j < 8; ++j) { lg[j] = p.sg_ln_g[lane + 64 * j]; lb[j] = p.sg_ln_b[lane + 64 * j]; }
    for (int ip = 0; ip < 8; ++ip) {
        const int s = wid * 16 + 2 * ip;
        float a0[8], a1[8]; float s0 = 0.f, s1 = 0.f;
#pragma unroll
        for (int j = 0; j < 8; ++j) { a0[j] = bf2f(Vg[(size_t)(r0 + s) * 512 + lane + 64 * j]); a1[j] = bf2f(Vg[(size_t)(r0 + s + 1) * 512 + lane + 64 * j]); s0 += a0[j]; s1 += a1[j]; }
        const float m0 = wave_sum(s0) * (1.0f / 512.0f), m1 = wave_sum(s1) * (1.0f / 512.0f);
        float q0 = 0.f, q1 = 0.f;
#pragma unroll
        for (int j = 0; j < 8; ++j) { a0[j] -= m0; a1[j] -= m1; q0 += a0[j] * a0[j]; q1 += a1[j] * a1[j]; }
        const float rs0 = __builtin_amdgcn_rsqf(wave_sum(q0) * (1.0f / 512.0f) + EPS), rs1 = __builtin_amdgcn_rsqf(wave_sum(q1) * (1.0f / 512.0f) + EPS);
#pragma unroll
        for (int j = 0; j < 8; ++j) *(unsigned*)(vT + (lane + 64 * j) * KS + s) = pk(a0[j] * rs0 * lg[j] + lb[j], a1[j] * rs1 * lg[j] + lb[j]);
    }
    __syncthreads();
    const int g = wid, cg0 = g * 64;
    for (int mt = 0; mt < 8; ++mt) {
        f32x4 acc[4];
#pragma unroll
        for (int nt = 0; nt < 4; ++nt) acc[nt] = (f32x4){0.f, 0.f, 0.f, 0.f};
#pragma unroll
        for (int ks = 0; ks < 4; ++ks) {
            if (32 * ks <= 16 * mt + 15) {
                const bf16x8 wf = *(const bf16x8*)(Wc + (size_t)(g * 128 + 16 * mt + fr) * 128 + 32 * ks + 8 * fq);
#pragma unroll
                for (int nt = 0; nt < 4; ++nt) { const bf16x8 vf = *(const bf16x8*)(vT + (cg0 + 16 * nt + fr) * KS + 32 * ks + 8 * fq); acc[nt] = MFMA16(vf, wf, acc[nt]); }
            }
        }
        const int t = 16 * mt + fr; const size_t row = (size_t)r0 + t; const float bs = p.sg_b[g * 128 + t];
#pragma unroll
        for (int nt = 0; nt < 4; ++nt) {
            const int cbase = cg0 + 16 * nt + 4 * fq;
            const u32x2 uu = *(const u32x2*)(Ug + row * 512 + cbase);
            u32x2 w; w.x = pk(bflo(uu.x) * (acc[nt][0] + bs), bfhi(uu.x) * (acc[nt][1] + bs)); w.y = pk(bflo(uu.y) * (acc[nt][2] + bs), bfhi(uu.y) * (acc[nt][3] + bs));
            *(u32x2*)(MIX + row * 1024 + cbase) = w;
        }
    }
    __syncthreads();
}
__device__ __forceinline__ void phase_scan_sg(const Params& p, unsigned char* shm) {
    if (blockIdx.x < 128) scan_bh(p, shm, blockIdx.x);
    else for (int it = blockIdx.x - 128; it < 512; it += gridDim.x - 128) sg_item(p, shm, it);
}

struct PrepEnt { const float* src; bf16_t* dst; const float* scale; int K, N, NP, blk, bs, boff, start, pad; };
#define PREP_DECODE(tix_, src_, dst_, scale_, K_, N_, blk_, bs_, boff_, tk_, tn_) do { \
    const int tq = (tix_); const int jt = (tq >= 704) + (tq >= 1408) + (tq >= 2112) + (tq >= 2944) + (tq >= 3200) + (tq >= 3904) + (tq >= 4608); \
    const PrepEnt* en = ptab + jt; src_ = en->src; dst_ = en->dst; scale_ = en->scale; K_ = en->K; N_ = en->N; blk_ = en->blk; bs_ = en->bs; boff_ = en->boff; \
    const int j = tq - en->start, ntn = en->NP / 64; tk_ = j / ntn; tn_ = j % ntn; } while (0)
__device__ __forceinline__ void prep_load(const float* __restrict__ src, const float* __restrict__ scale, int N, int tk, int tn, int t, float (&v)[8]) {
    const int nl = t & 63, n = tn * 64 + nl;
#pragma unroll
    for (int i = 0; i < 8; ++i) { const int kk = (t >> 6) + 8 * i, k = tk * 64 + kk; float a = (n < N) ? src[(size_t)k * N + n] : 0.f; if (scale) a *= scale[k]; v[i] = a; }
}
__device__ __forceinline__ void prep_emit(bf16_t* __restrict__ dst, int K, int blk, int bs, int boff, int tk, int tn, int t, const float (&v)[8], float* tile) {
    const int nl = t & 63;
#pragma unroll
    for (int i = 0; i < 8; ++i) tile[((t >> 6) + 8 * i) * 65 + nl] = v[i];
    __syncthreads();
    const int nn = t >> 3, kg = t & 7, nrow = tn * 64 + nn, drow = (nrow / blk) * bs + (nrow % blk) + boff;
    float o[8];
#pragma unroll
    for (int j = 0; j < 8; ++j) o[j] = tile[(kg * 8 + j) * 65 + nn];
    u32x4 w; w.x = pk(o[0], o[1]); w.y = pk(o[2], o[3]); w.z = pk(o[4], o[5]); w.w = pk(o[6], o[7]);
    *(u32x4*)(dst + ((size_t)(drow >> 8) * (K >> 6) + tk) * 16384 + (drow & 255) * 64 + kg * 8) = w;
}
__device__ __forceinline__ void phase_prep(const Params& p, float* tiles) {
    unsigned char* ws = p.ws;
    {
        const int t = otid(); int tix = blockIdx.x, par = 0;
        PrepEnt* ptab = (PrepEnt*)(tiles + 2 * 64 * 65);
        if (t == 0) {
            constexpr int BIG = 1 << 30;
            ptab[0] = PrepEnt{p.ffn1_wg, (bf16_t*)(ws + WS_BT1), p.ffn1_norm, 1024, 2816, 2816, 128, 256, 0, 0, 0};
            ptab[1] = PrepEnt{p.ffn1_wu, (bf16_t*)(ws + WS_BT1), p.ffn1_norm, 1024, 2816, 2816, 128, 256, 128, 704, 0};
            ptab[2] = PrepEnt{p.ffn1_wd, (bf16_t*)(ws + WS_BT2), nullptr, 2816, 1024, 1024, BIG, 0, 0, 1408, 0};
            ptab[3] = PrepEnt{p.w_in, (bf16_t*)(ws + WS_BT3), p.mix_norm, 1024, NIN, NINP, BIG, 0, 0, 2112, 0};
            ptab[4] = PrepEnt{p.w_out, (bf16_t*)(ws + WS_BT4), nullptr, 1024, 1024, 1024, BIG, 0, 0, 2944, 0};
            ptab[5] = PrepEnt{p.ffn2_wg, (bf16_t*)(ws + WS_BT5), p.ffn2_norm, 1024, 2816, 2816, 128, 256, 0, 3200, 0};
            ptab[6] = PrepEnt{p.ffn2_wu, (bf16_t*)(ws + WS_BT5), p.ffn2_norm, 1024, 2816, 2816, 128, 256, 128, 3904, 0};
            ptab[7] = PrepEnt{p.ffn2_wd, (bf16_t*)(ws + WS_BT6), nullptr, 2816, 1024, 1024, BIG, 0, 0, 4608, 0};
        }
        __syncthreads();
        const float* src; bf16_t* dst; const float* scale; int K, N, blk, bs, boff, tk, tn; float v[8];
        PREP_DECODE(tix < 5312 ? tix : 0, src, dst, scale, K, N, blk, bs, boff, tk, tn);
        if (tix < 5312) prep_load(src, scale, N, tk, tn, t, v);
        while (tix < 5312) {
            const int nx = tix + gridDim.x;
            const float* src2 = src; bf16_t* dst2 = dst; const float* scale2 = scale; int K2 = K, N2 = N, blk2 = blk, bs2 = bs, boff2 = boff, tk2 = tk, tn2 = tn; float vn[8];
#pragma unroll
            for (int i = 0; i < 8; ++i) vn[i] = 0.f;
            if (nx < 5312) { PREP_DECODE(nx, src2, dst2, scale2, K2, N2, blk2, bs2, boff2, tk2, tn2); prep_load(src2, scale2, N2, tk2, tn2, t, vn); }
            prep_emit(dst, K, blk, bs, boff, tk, tn, t, v, tiles + par * (64 * 65));
            src = src2; dst = dst2; scale = scale2; K = K2; N = N2; blk = blk2; bs = bs2; boff = boff2; tk = tk2; tn = tn2;
#pragma unroll
            for (int i = 0; i < 8; ++i) v[i] = vn[i];
            tix = nx; par ^= 1;
        }
        __syncthreads();
    }
    { bf16_t* wc = (bf16_t*)(ws + WS_WC);
      for (int i = blockIdx.x * 512 + otid(); i < 8 * 128 * 128; i += gridDim.x * 512) { const int t = (i >> 7) & 127, s = i & 127; wc[i] = (t >= s) ? f2bf(p.sg_w[i]) : (bf16_t)0; } }
    { bf16_t* xb = (bf16_t*)(ws + WS_XB); float* ssq = (float*)(ws + WS_SSQ);
      const int tid = otid(), wid = tid >> 6, lane = tid & 63;
      int row = blockIdx.x * 8 + wid; f32x4 v[4];
#pragma unroll
      for (int i = 0; i < 4; ++i) v[i] = ((const f32x4*)(p.x + (size_t)row * DM))[lane + 64 * i];
      while (row < MTOK) {
          const int nrow = row + gridDim.x * 8; f32x4 vn[4];
#pragma unroll
          for (int i = 0; i < 4; ++i) vn[i] = v[i];
          if (nrow < MTOK) {
#pragma unroll
              for (int i = 0; i < 4; ++i) vn[i] = ((const f32x4*)(p.x + (size_t)nrow * DM))[lane + 64 * i];
          }
          float s = 0.f;
#pragma unroll
          for (int i = 0; i < 4; ++i) { s += v[i][0] * v[i][0] + v[i][1] * v[i][1] + v[i][2] * v[i][2] + v[i][3] * v[i][3];
              u32x2 w; w.x = pk(v[i][0], v[i][1]); w.y = pk(v[i][2], v[i][3]); *(u32x2*)(xb + (size_t)row * DM + (lane + 64 * i) * 4) = w; }
          s = wave_sum(s);
          if (lane == 0) { ssq[row] = s; ssq[row + (1 << 20)] = 0.f; ssq[row + (2 << 20)] = 0.f; ssq[row + (3 << 20)] = 0.f; }
#pragma unroll
          for (int i = 0; i < 4; ++i) v[i] = vn[i];
          row = nrow;
      } }
}
__device__ __forceinline__ void phase_final(const Params& p) {
    const float* ssq = (const float*)(p.ws + WS_SSQ + 3 * 4 * MiB); const bf16_t* xb = (const bf16_t*)(p.ws + WS_XB);
    const int tid = otid(), wid = tid >> 6, lane = tid & 63;
    f32x4 g[4];
#pragma unroll
    for (int i = 0; i < 4; ++i) g[i] = ((const f32x4*)p.final_norm)[2 * lane + 128 * (i >> 1) + (i & 1)];
    for (int row0 = (blockIdx.x * 8 + wid) * 4; row0 < MTOK; row0 += gridDim.x * 32) {
        u32x4 v[4][2]; float rs[4];
#pragma unroll
        for (int r = 0; r < 4; ++r) { const u32x4* xr = (const u32x4*)(xb + (size_t)(row0 + r) * DM); v[r][0] = xr[lane]; v[r][1] = xr[lane + 64]; rs[r] = ssq[row0 + r]; }
#pragma unroll
        for (int r = 0; r < 4; ++r) {
            const float rr = __builtin_amdgcn_rsqf(rs[r] * (1.0f / 1024.0f) + EPS);
            f32x4* o = (f32x4*)(p.out + (size_t)(row0 + r) * DM);
#pragma unroll
            for (int h = 0; h < 2; ++h) {
                const u32x4 q = v[r][h];
                const f32x4 a = (f32x4){bflo(q.x), bfhi(q.x), bflo(q.y), bfhi(q.y)} * rr * g[2 * h], b = (f32x4){bflo(q.z), bfhi(q.z), bflo(q.w), bfhi(q.w)} * rr * g[2 * h + 1];
                __builtin_nontemporal_store(a, &o[2 * (lane + 64 * h)]); __builtin_nontemporal_store(b, &o[2 * (lane + 64 * h) + 1]);
            }
        }
    }
}


__device__ __forceinline__ void phase_ba(const Params& p, unsigned char* shm) {
    unsigned char* ws = p.ws;
    const int tid = otid(), wid = tid >> 6, lane = tid & 63, fr = lane & 15, fq = lane >> 4;
    const bf16_t* XB = (const bf16_t*)(ws + WS_XB); const bf16_t* BT = (const bf16_t*)(ws + WS_BT3) + (size_t)12 * 16 * 16384  ; float* BA = (float*)(ws + WS_BA);
    const float* ssq = (const float*)(ws + WS_SSQ + 4 * MiB);
    constexpr int BST = 2064;
#pragma unroll
    for (int i = 0; i < 4; ++i) { const int c = tid + 512 * i, row = c >> 7, k0 = (c & 127) * 8;
        *(u32x4*)(shm + row * BST + k0 * 2) = *(const u32x4*)(BT + (size_t)(k0 >> 6) * 16384 + row * 64 + (k0 & 63)); }
    __syncthreads();
    for (int panel = blockIdx.x; panel < MTOK / 256; panel += gridDim.x) {
#pragma unroll
        for (int mt = 0; mt < 2; ++mt) {
            const int rbase = panel * 256 + wid * 32 + mt * 16;
            const bf16_t* ap = XB + (size_t)(rbase + fr) * DM + 8 * fq;
            bf16x8 af[32];
#pragma unroll
            for (int ks = 0; ks < 32; ++ks) af[ks] = *(const bf16x8*)(ap + 32 * ks);
            f32x4 acc = {0.f, 0.f, 0.f, 0.f};
#pragma unroll
            for (int ks = 0; ks < 32; ++ks) acc = MFMA16(af[ks], *(const bf16x8*)(shm + fr * BST + (32 * ks + 8 * fq) * 2), acc);
            if (fr < 8) {
                const int hh = fr & 3; const float al = p.a_log[hh], db = p.dt_bias[hh];
#pragma unroll
                for (int r = 0; r < 4; ++r) {
                    const int row = rbase + 4 * fq + r; const float v = acc[r] * rstd_of(ssq, row);
                    float o;
                    if (fr < 4) o = 1.0f / (1.0f + __expf(-v));
                    else { const float av = v + db; o = -__expf(al) * (fmaxf(av, 0.f) + log1pf(__expf(-fabsf(av)))); }
                    BA[(size_t)row * 8 + fr] = o;
                }
            }
        }
    }
    __syncthreads();
}
#define XB_TMO      128
#define XB_XCNT(j)  (256  + 64 * (j))
#define XB_XSUB(j)  (1280 + 64 * (j))
#define XB_XGEN(j)  (2304 + 64 * (j))
#define XB_TOP      3328
#define XB_TOPGEN   3392
#define XCD_BAR_WORDS 3456
#define XB_SPIN_CAP (1u << 18)

__device__ __forceinline__ unsigned xb_ld(unsigned* p)              { return __hip_atomic_load(p, __ATOMIC_RELAXED, __HIP_MEMORY_SCOPE_AGENT); }
__device__ __forceinline__ unsigned xb_add(unsigned* p, unsigned v) { return __hip_atomic_fetch_add(p, v, __ATOMIC_RELAXED, __HIP_MEMORY_SCOPE_AGENT); }
__device__ __forceinline__ unsigned xb_xcc_id() { return (unsigned)__builtin_amdgcn_s_getreg((3 << 11) | 20) & 0xFu; }
#define XB_SPIN(cond, bar) do { unsigned _sp = 0; while (cond) { __builtin_amdgcn_s_sleep(1); \
    if ((++_sp & 255u) == 0u) { if (xb_ld(&(bar)[XB_TMO])) break; if (_sp > XB_SPIN_CAP) { atomicAdd(&(bar)[XB_TMO], 1u); break; } } } } while (0)

struct XcdBarrier {
    unsigned* bar; unsigned x;
    volatile LAS unsigned* st;
};

__device__ __forceinline__ XcdBarrier xcd_barrier_post(unsigned* bar, volatile LAS unsigned* st) {
    XcdBarrier b; b.bar = bar; b.x = xb_xcc_id(); b.st = st;
    if (threadIdx.x == 0) (void)xb_add(&bar[XB_XCNT(b.x)], 1u);
    return b;
}
__device__ __forceinline__ void xcd_barrier_complete(unsigned* bar, unsigned x, unsigned& nloc, unsigned& nx) {
    const unsigned G = gridDim.x * gridDim.y * gridDim.z;
    unsigned sum, cnt, mine, sp = 0u;
    for (;;) {
        sum = 0u; cnt = 0u; mine = 0u;
#pragma unroll
        for (unsigned j = 0; j < 16; ++j) { const unsigned c = xb_ld(&bar[XB_XCNT(j)]); sum += c; cnt += (c > 0u) ? 1u : 0u; mine = (j == x) ? c : mine; }
        if (sum == G) break;
        __builtin_amdgcn_s_sleep(1);
        if ((++sp & 255u) == 0u) { if (xb_ld(&bar[XB_TMO])) break; if (sp > XB_SPIN_CAP) { atomicAdd(&bar[XB_TMO], 1u); break; } }
    }
    nloc = mine > 0u ? mine : 1u; nx = cnt > 0u ? cnt : 1u;
}

__device__ __forceinline__ void xcd_barrier(const XcdBarrier& b) {
    asm volatile("s_waitcnt vmcnt(0)" ::: "memory");
    __syncthreads();
    if (threadIdx.x == 0) {
        unsigned* bar = b.bar;
        __builtin_amdgcn_s_waitcnt(0);
        unsigned nloc = b.st[0], nx = b.st[1];
        if (nloc == 0u) { xcd_barrier_complete(bar, b.x, nloc, nx); b.st[0] = nloc; b.st[1] = nx; }
        const unsigned old = xb_add(&bar[XB_XSUB(b.x)], 1u);
        const unsigned gen = old / nloc;
        if (old + 1u == (gen + 1u) * nloc) {
            __builtin_amdgcn_fence(__ATOMIC_RELEASE, "agent");
            asm volatile("s_waitcnt vmcnt(0)" ::: "memory");
            const unsigned og = xb_add(&bar[XB_TOP], 1u);
            const unsigned tg = og / nx;
            if (og + 1u == (tg + 1u) * nx) xb_add(&bar[XB_TOPGEN], 1u);
            else XB_SPIN(xb_ld(&bar[XB_TOPGEN]) == tg, bar);
            __builtin_amdgcn_fence(__ATOMIC_ACQUIRE, "agent");
            xb_add(&bar[XB_XGEN(b.x)], 1u);
            asm volatile("s_waitcnt vmcnt(0)" ::: "memory");
        } else {
            XB_SPIN(xb_ld(&bar[XB_XGEN(b.x)]) == gen, bar);
            __builtin_amdgcn_fence(__ATOMIC_ACQUIRE, "agent");
            asm volatile("s_waitcnt vmcnt(0)" ::: "memory");
        }
    }
    __syncthreads();
}

constexpr int LDS_BAR_ST = 158 * 1024;
constexpr int LDS_BYTES = 158 * 1024 + 64;
constexpr int NPHASE = 10;
template <int PH> __device__ __forceinline__ void run_phase(const Params& p, unsigned char* shm) {
    unsigned char* ws = p.ws;
    pg8::StaticOrder S;
    float* ssq0 = (float*)(ws + WS_SSQ); float* ssq1 = (float*)(ws + WS_SSQ + 4 * MiB); float* ssq2 = (float*)(ws + WS_SSQ + 8 * MiB); float* ssq3 = (float*)(ws + WS_SSQ + 12 * MiB);
    if constexpr (PH == 0) { phase_prep(p, (float*)shm); }
    if constexpr (PH == 1) {
        Gemm g{(const bf16_t*)(ws + WS_XB), (const bf16_t*)(ws + WS_BT1), MTOK, 2 * DFF, DM}; S.init(g.M, g.N, (int)gridDim.x, (int)blockIdx.x);
        EpiGateUp E{(bf16_t*)(ws + WS_R1), ssq0};
        pg8::gemm_phase<EpiGateUp, pg8::StaticOrder, false>((PG8_LAS unsigned char*)shm, g, S, E, nullptr);
    }
    if constexpr (PH == 2) {
        Gemm g{(const bf16_t*)(ws + WS_R1), (const bf16_t*)(ws + WS_BT2), MTOK, DM, DFF}; S.init(g.M, g.N, (int)gridDim.x, (int)blockIdx.x);
        EpiResid<false> E{nullptr, (bf16_t*)(ws + WS_XB), ssq1, 0.5f};
        pg8::gemm_phase<EpiResid<false>, pg8::StaticOrder, false>((PG8_LAS unsigned char*)shm, g, S, E, nullptr);
    }
    if constexpr (PH == 3) {
        Gemm g{(const bf16_t*)(ws + WS_XB), (const bf16_t*)(ws + WS_BT3), MTOK, 3072, DM}; S.init(g.M, g.N, (int)gridDim.x, (int)blockIdx.x);
        EpiInProj E{ws, ssq1, p.a_log, p.dt_bias};
        pg8::gemm_phase<EpiInProj, pg8::StaticOrder, false>((PG8_LAS unsigned char*)shm, g, S, E, nullptr);
        phase_ba(p, shm);
    }
    if constexpr (PH == 4) { phase_dnpre(p, shm); }
    if constexpr (PH == 5) { phase_scan_sg(p, shm); }
    if constexpr (PH == 6) {
        Gemm g{(const bf16_t*)(ws + WS_MIX), (const bf16_t*)(ws + WS_BT4), MTOK, DM, DM}; S.init(g.M, g.N, (int)gridDim.x, (int)blockIdx.x);
        EpiResid<false> E{nullptr, (bf16_t*)(ws + WS_XB), ssq2, 1.0f};
        pg8::gemm_phase<EpiResid<false>, pg8::StaticOrder, false>((PG8_LAS unsigned char*)shm, g, S, E, nullptr);
    }
    if constexpr (PH == 7) {
        Gemm g{(const bf16_t*)(ws + WS_XB), (const bf16_t*)(ws + WS_BT5), MTOK, 2 * DFF, DM}; S.init(g.M, g.N, (int)gridDim.x, (int)blockIdx.x);
        EpiGateUp E{(bf16_t*)(ws + WS_R1), ssq2};
        pg8::gemm_phase<EpiGateUp, pg8::StaticOrder, false>((PG8_LAS unsigned char*)shm, g, S, E, nullptr);
    }
    if constexpr (PH == 8) {
        Gemm g{(const bf16_t*)(ws + WS_R1), (const bf16_t*)(ws + WS_BT6), MTOK, DM, DFF}; S.init(g.M, g.N, (int)gridDim.x, (int)blockIdx.x);
        EpiResid<false> E{nullptr, (bf16_t*)(ws + WS_XB), ssq3, 0.5f};
        pg8::gemm_phase<EpiResid<false>, pg8::StaticOrder, false>((PG8_LAS unsigned char*)shm, g, S, E, nullptr);
    }
    if constexpr (PH == 9) { phase_final(p); }
}
template <int PH> __global__ __launch_bounds__(512, 2) void k_phase(Params p) {
    extern __shared__ __attribute__((aligned(16))) unsigned char shm[];
    run_phase<PH>(p, shm);
}
__global__ __launch_bounds__(512, 2) void k_mega(Params p) {
    extern __shared__ __attribute__((aligned(16))) unsigned char shm[];
    cg::grid_group grid = cg::this_grid();
    volatile LAS unsigned* st = (volatile LAS unsigned*)(LAS unsigned char*)(shm + LDS_BAR_ST);
    if (threadIdx.x == 0) { st[0] = 0u; st[1] = 0u; }
    __syncthreads();
    const XcdBarrier xb = xcd_barrier_post((unsigned*)(p.ws + WS_BAR), st);
    run_phase<0>(p, shm); grid.sync();
    run_phase<1>(p, shm); xcd_barrier(xb);
    run_phase<2>(p, shm); xcd_barrier(xb);
    run_phase<3>(p, shm); xcd_barrier(xb);
    run_phase<4>(p, shm); xcd_barrier(xb);
    run_phase<5>(p, shm); xcd_barrier(xb);
    run_phase<6>(p, shm); xcd_barrier(xb);
    run_phase<7>(p, shm); xcd_barrier(xb);
    run_phase<8>(p, shm); xcd_barrier(xb);
    run_phase<9>(p, shm);
}

#ifndef MEGA
#define MEGA 1
#endif
template <int PH> static void launch_phase(const Params& p, hipStream_t stream) {
    static bool attr = false;
    if (!attr) { (void)hipFuncSetAttribute((const void*)k_phase<PH>, hipFuncAttributeMaxDynamicSharedMemorySize, LDS_BYTES); attr = true; }
    hipLaunchKernelGGL(k_phase<PH>, dim3(256), dim3(512), LDS_BYTES, stream, p);
}
extern "C" void kernel_launch(void* const* d_in, const int* in_sizes, int n_in, void* d_out, int out_size, void* d_ws, size_t ws_size, hipStream_t stream) {
    Params p{};
    const float** f = (const float**)&p;
    for (int i = 0; i < 21; ++i) f[i] = (const float*)d_in[i];
    p.out = (float*)d_out; p.ws = (unsigned char*)d_ws;
    if (ws_size < WS_END) { fprintf(stderr, "kernel_launch: workspace too small: %zu < %zu\n", ws_size, (size_t)WS_END); return; }
#if MEGA
    static int grid = 0;
    if (!grid) {
        (void)hipFuncSetAttribute((const void*)k_mega, hipFuncAttributeMaxDynamicSharedMemorySize, LDS_BYTES);
        int dev = 0, cus = 0, per_cu = 0; (void)hipGetDevice(&dev); (void)hipDeviceGetAttribute(&cus, hipDeviceAttributeMultiprocessorCount, dev);
        (void)hipOccupancyMaxActiveBlocksPerMultiprocessor(&per_cu, (const void*)k_mega, 512, LDS_BYTES);
        if (per_cu < 1) fprintf(stderr, "kernel_launch: occupancy query says %d blocks per CU\n", per_cu);
        grid = cus;
    }
    (void)hipMemsetAsync((unsigned char*)d_ws + WS_BAR, 0, XCD_BAR_WORDS * sizeof(unsigned), stream);
    void* args[] = {(void*)&p};
    hipError_t e = hipLaunchCooperativeKernel((const void*)k_mega, dim3(grid), dim3(512), args, LDS_BYTES, stream);
    if (e != hipSuccess) fprintf(stderr, "cooperative launch failed: %s (grid %d)\n", hipGetErrorString(e), grid);
#else
    launch_phase<0>(p, stream); launch_phase<1>(p, stream); launch_phase<2>(p, stream); launch_phase<3>(p, stream); launch_phase<4>(p, stream); launch_phase<5>(p, stream); launch_phase<6>(p, stream); launch_phase<7>(p, stream); launch_phase<8>(p, stream); launch_phase<9>(p, stream);
#endif
}
```

```cpp
#include <hip/hip_runtime.h>
#include <hip/hip_cooperative_groups.h>
#include <cstdio>
namespace cg = cooperative_groups;
__device__ __forceinline__ int otid() { int t = (int)threadIdx.x; asm volatile("" : "+v"(t)); return t; }
namespace pg8 {
#define PG8_LAS __attribute__((address_space(3)))
typedef unsigned short bf16_t;
typedef short bf16x8 __attribute__((ext_vector_type(8)));
typedef float f32x4 __attribute__((ext_vector_type(4)));
typedef unsigned u32x4 __attribute__((ext_vector_type(4)));
constexpr int BM = 256, BK = 64, HALF = 128, HTB = HALF * BK * 2  , STAGE_BYTES = 8 * HTB, NXCD = 8, WGM = 4;

__host__ __device__ __forceinline__ int lds_byte(int r, int c) { const int st = (r >> 4) * 2 + (c >> 5), rr = r & 15, cc = c & 31, ob = rr * 64 + cc * 2; return st * 1024 + (ob ^ (((ob >> 9) & 1) << 5)); }
__host__ __device__ __forceinline__ void stage_rc(int b, int& R, int& C) { const int st = b / 1024, sb = b % 1024, swz = sb ^ (((sb >> 9) & 1) << 5); R = (st >> 1) * 16 + swz / 64; C = (st & 1) * 32 + (swz % 64) / 2; }
__host__ __device__ __forceinline__ int perm32(int rho) { const int n = rho >> 4, i = rho & 15; return 8 * (i >> 2) + 4 * n + (i & 3); }

struct Unit { int pm, pn; };
struct Gemm { const bf16_t* A; const bf16_t* Bt; int M, N, K; };

struct StaticOrder {
    int nM, nN, nwg, G, c;
    __host__ __device__ void init(int M, int N, int G_, int c_) { nM = M / BM; nN = N / BM; nwg = nM * nN; G = G_; c = c_; }
    __host__ __device__ bool next(int i, Unit& u) const {
        const long L = (long)i * G + c; if (L >= nwg) return false;
        int wgid = (int)L; { const int q = nwg / NXCD, r = nwg % NXCD, xcd = wgid % NXCD, off = wgid / NXCD; wgid = (xcd < r ? xcd * (q + 1) : r * (q + 1) + (xcd - r) * q) + off; }
        const int nig = WGM * nN, gid = wgid / nig, fm = gid * WGM, gsz = (nM - fm) < WGM ? (nM - fm) : WGM;
        u.pm = fm + ((wgid % nig) % gsz); u.pn = (wgid % nig) / gsz; return true;
    }
    __device__ __forceinline__ void a_ready(const Unit&) const {}
    __device__ __forceinline__ void done(const Unit&) const {}
};
__device__ __forceinline__ unsigned cvt_pk_bf16(float lo, float hi) { unsigned r; asm volatile("v_cvt_pk_bf16_f32 %0, %1, %2" : "=v"(r) : "v"(lo), "v"(hi)); return r; }
template <class Epi, class Sched, bool STAMP = false>
__device__ __forceinline__ void gemm_phase(PG8_LAS unsigned char* lds, const Gemm g, const Sched& S, const Epi& E, unsigned long long* stamps) {
    const int tid = otid(), wid = __builtin_amdgcn_readfirstlane(tid >> 6), lane = tid & 63, wr = wid >> 2, wc = wid & 3, fr = lane & 15, fq = lane >> 4;
    const int K = g.K, nt = K / BK;
    int ts_lo = 0, ts_hi = 0, nts = 0; const unsigned long long rt_entry = STAMP ? (unsigned long long)wall_clock64() : 0ull;
#define PG8_STAMP() do { if (STAMP && wid == 0 && nts < 64) { const unsigned long long _c = (unsigned long long)clock64(); \
        ts_lo = (lane == nts) ? (int)(unsigned)_c : ts_lo; ts_hi = (lane == nts) ? (int)(unsigned)(_c >> 32) : ts_hi; ++nts; } } while (0)
    PG8_STAMP();
    unsigned voffA[2], voffB[2];
#pragma unroll
    for (int i = 0; i < 2; ++i) { int R, C; stage_rc(tid * 16 + i * 8192, R, C); const int Rb = Epi::PERM ? ((R & ~31) + perm32(R & 31)) : R;
        voffA[i] = (unsigned)(R * K + C) * 2u; voffB[i] = (unsigned)(Rb * BK + C) * 2u; }
    const size_t kstep = (size_t)(BK * 2);
    const size_t hstep = (size_t)HALF * K * 2;
    const size_t tstep = 2 * hstep;
    const size_t kstepB = (size_t)BM * BK * 2, hstepB = (size_t)HALF * BK * 2, tstepB = (size_t)(K / BK) * kstepB;
    const unsigned ldsw = (unsigned)wid * 1024u;
    const int aoff = lds_byte(wr * 64 + fr, fq * 8), boff = lds_byte(wc * 32 + fr, fq * 8);
#define PG8_SA(b, h) (((b) * 2 + (h)) * HTB)
#define PG8_SB(b, h) ((4 + (b) * 2 + (h)) * HTB)
#define PG8_STAGE(bufoff, gbase, voff) do { _Pragma("unroll") for (int _i = 0; _i < 2; ++_i) \
        __builtin_amdgcn_global_load_lds((const unsigned*)((const char*)(gbase) + (voff)[_i]), (PG8_LAS unsigned*)(lds + (bufoff) + ldsw + _i * 8192), 16, 0, 0); } while (0)
#define PG8_LDA(dst, b, h) do { _Pragma("unroll") for (int m = 0; m < 4; ++m) _Pragma("unroll") for (int k = 0; k < 2; ++k) dst[m][k] = *(const PG8_LAS bf16x8*)(lds + PG8_SA(b, h) + aoff + m * 2048 + k * 1024); } while (0)
#define PG8_LDB(dst, b, h) do { _Pragma("unroll") for (int n = 0; n < 2; ++n) _Pragma("unroll") for (int k = 0; k < 2; ++k) dst[n][k] = *(const PG8_LAS bf16x8*)(lds + PG8_SB(b, h) + boff + n * 2048 + k * 1024); } while (0)
#define PG8_MMA(ai, bj, At, Bt) do { __builtin_amdgcn_s_setprio(1); _Pragma("unroll") for (int m = 0; m < 4; ++m) _Pragma("unroll") for (int n = 0; n < 2; ++n) _Pragma("unroll") for (int k = 0; k < 2; ++k) \
        acc[ai][bj][m][n] = __builtin_amdgcn_mfma_f32_16x16x32_bf16(Bt[n][k], At[m][k], acc[ai][bj][m][n], 0, 0, 0); __builtin_amdgcn_s_setprio(0); } while (0)
#define PG8_WAIT_V(n) asm volatile("s_waitcnt vmcnt(" #n ")" ::: "memory")
#define PG8_WAIT_L(n) asm volatile("s_waitcnt lgkmcnt(" #n ")" ::: "memory")
#define PG8_BAR __builtin_amdgcn_s_barrier()
#define PG8_SCHED __builtin_amdgcn_sched_barrier(0)
    Unit cur, nxt; int ui = 0;
    if (!S.next(0, cur)) return;
    f32x4 acc[2][2][4][2];
#pragma unroll
    for (int a = 0; a < 2; ++a)
#pragma unroll
        for (int b = 0; b < 2; ++b)
#pragma unroll
            for (int m = 0; m < 4; ++m)
#pragma unroll
                for (int n = 0; n < 2; ++n) acc[a][b][m][n] = (f32x4){0.f, 0.f, 0.f, 0.f};
    bf16x8 At[4][2], B0[2][2], B1[2][2];
    float epre[8];
#pragma unroll
    for (int i = 0; i < 8; ++i) epre[i] = 0.f;
    const char* cA = (const char*)g.A + (size_t)cur.pm * tstep; const char* cB = (const char*)g.Bt + (size_t)cur.pn * tstepB;
    S.a_ready(cur);
    PG8_STAGE(PG8_SB(0, 0), cB, voffB); PG8_STAGE(PG8_SA(0, 0), cA, voffA); PG8_STAGE(PG8_SB(0, 1), cB + hstepB, voffB); PG8_STAGE(PG8_SA(0, 1), cA + hstep, voffA);
    if (wr == 1) PG8_BAR;
    PG8_WAIT_V(4); PG8_BAR;
    PG8_STAGE(PG8_SB(1, 0), cB + kstepB, voffB); PG8_STAGE(PG8_SA(1, 0), cA + kstep, voffA); PG8_STAGE(PG8_SB(1, 1), cB + hstepB + kstepB, voffB);
    PG8_WAIT_V(6); PG8_BAR;
    PG8_STAMP();
    for (;;) {
        const bool has_next = S.next(ui + 1, nxt);
        const char* nA = has_next ? (const char*)g.A + (size_t)nxt.pm * tstep : cA; const char* nB = has_next ? (const char*)g.Bt + (size_t)nxt.pn * tstepB : cB;
        for (int t = 0; t < nt; t += 2) {
            const bool last = (t == nt - 2);
            const char* a1 = cA + (size_t)(t + 1) * kstep;
            const char* a2 = last ? nA : cA + (size_t)(t + 2) * kstep; const char* b2 = last ? nB : cB + (size_t)(t + 2) * kstepB;
            const char* a3 = a2 + kstep; const char* b3 = b2 + kstepB;
            if (last && has_next) S.a_ready(nxt);
            if (last) E.prefetch(cur, wr, wc, fr, fq, epre);
            PG8_LDB(B0, 0, 0); PG8_SCHED; PG8_LDA(At, 0, 0); PG8_STAGE(PG8_SA(1, 1), a1 + hstep, voffA);
            PG8_WAIT_L(8); PG8_BAR; PG8_WAIT_L(0); PG8_MMA(0, 0, At, B0); PG8_BAR; PG8_SCHED;
            PG8_LDB(B1, 0, 1); PG8_STAGE(PG8_SB(0, 0), b2, voffB);
            PG8_BAR; PG8_WAIT_L(0); PG8_MMA(0, 1, At, B1); PG8_BAR;
            PG8_LDA(At, 0, 1); PG8_STAGE(PG8_SA(0, 0), a2, voffA);
            PG8_BAR; PG8_WAIT_L(0); PG8_MMA(1, 0, At, B0); PG8_BAR; PG8_SCHED;
            PG8_STAGE(PG8_SB(0, 1), b2 + hstepB, voffB);
            PG8_WAIT_V(6); PG8_BAR; PG8_MMA(1, 1, At, B1); PG8_BAR;
            PG8_LDB(B0, 1, 0); PG8_SCHED; PG8_LDA(At, 1, 0); PG8_STAGE(PG8_SA(0, 1), a2 + hstep, voffA);
            PG8_WAIT_L(8); PG8_BAR; PG8_WAIT_L(0); PG8_MMA(0, 0, At, B0); PG8_BAR; PG8_SCHED;
            PG8_LDB(B1, 1, 1); PG8_STAGE(PG8_SB(1, 0), b3, voffB);
            PG8_BAR; PG8_WAIT_L(0); PG8_MMA(0, 1, At, B1); PG8_BAR;
            PG8_LDA(At, 1, 1); PG8_STAGE(PG8_SA(1, 0), a3, voffA);
            PG8_BAR; PG8_WAIT_L(0); PG8_MMA(1, 0, At, B0); PG8_BAR; PG8_SCHED;
            PG8_STAGE(PG8_SB(1, 1), b3 + hstepB, voffB);
            PG8_WAIT_V(6); PG8_BAR; PG8_MMA(1, 1, At, B1); PG8_BAR;
        }
        PG8_STAMP();
        if constexpr (!Epi::AFTER_DRAIN) { E(acc, cur, wr, wc, fr, fq, epre); S.done(cur); }
        PG8_STAMP();
        if (!has_next) break;
#pragma unroll
        for (int a = 0; a < 2; ++a)
#pragma unroll
            for (int b = 0; b < 2; ++b)
#pragma unroll
                for (int m = 0; m < 4; ++m)
#pragma unroll
                    for (int n = 0; n < 2; ++n) acc[a][b][m][n] = (f32x4){0.f, 0.f, 0.f, 0.f};
        cur = nxt; cA = nA; cB = nB; ++ui;
    }
    PG8_WAIT_V(0);
    if (wr == 0) PG8_BAR;
    PG8_BAR;
    if constexpr (Epi::AFTER_DRAIN) { E.fused(acc, cur, wr, wc, fr, fq, lds, wid, lane); S.done(cur); }
    PG8_STAMP();
    if (STAMP && wid == 0) { stamps[lane] = lane < nts ? (((unsigned long long)(unsigned)ts_hi << 32) | (unsigned)ts_lo) : 0ull;
        if (lane == 62) stamps[62] = rt_entry; if (lane == 63) stamps[63] = (unsigned long long)wall_clock64(); }
#undef PG8_STAMP
#undef PG8_SA
#undef PG8_SB
#undef PG8_STAGE
#undef PG8_LDA
#undef PG8_LDB
#undef PG8_MMA
#undef PG8_WAIT_V
#undef PG8_WAIT_L
#undef PG8_BAR
#undef PG8_SCHED
}
}

using pg8::bf16_t; using pg8::bf16x8; using pg8::f32x4; using pg8::u32x4; using pg8::Unit; using pg8::Gemm; using pg8::cvt_pk_bf16;
typedef unsigned u32x2 __attribute__((ext_vector_type(2)));
typedef short s16x4 __attribute__((ext_vector_type(4)));
#define LAS __attribute__((address_space(3)))

constexpr int MTOK = 65536, DM = 1024, DFF = 2816, NIN = 3080, NINP = 3328;
constexpr float EPS = 1e-6f;
constexpr size_t MiB = 1024ull * 1024ull;
constexpr size_t WS_XB = 0, WS_R1 = 128 * MiB, WS_DN = 512 * MiB, WS_MIX = 800 * MiB, WS_W = 928 * MiB;
constexpr size_t WS_BT1 = WS_W, WS_BT2 = WS_BT1 + 5632ull * 1024 * 2, WS_BT3 = WS_BT2 + 1024ull * 2816 * 2, WS_BT4 = WS_BT3 + 3328ull * 1024 * 2,
                 WS_BT5 = WS_BT4 + 1024ull * 1024 * 2, WS_BT6 = WS_BT5 + 5632ull * 1024 * 2, WS_WEND = WS_BT6 + 1024ull * 2816 * 2;
constexpr size_t WS_WC = 970 * MiB, WS_SSQ = 971 * MiB  , WS_BA = 987 * MiB  , WS_GL = 989 * MiB, WS_BAR = 989 * MiB + 65536  , WS_END = 990 * MiB;
static_assert(WS_WEND <= WS_WC, "weights overflow");
constexpr size_t WS_U = WS_R1, WS_V = WS_U + 64 * MiB, WS_QKV = WS_V + 64 * MiB, WS_Z = WS_QKV + 192 * MiB;

struct Params {
    const float* x; const float* ffn1_norm; const float* ffn1_wg; const float* ffn1_wu; const float* ffn1_wd; const float* mix_norm; const float* w_in; const float* conv_w;
    const float* a_log; const float* dt_bias; const float* dn_norm; const float* sg_ln_g; const float* sg_ln_b; const float* sg_w; const float* sg_b; const float* w_out;
    const float* ffn2_norm; const float* ffn2_wg; const float* ffn2_wu; const float* ffn2_wd; const float* final_norm;
    float* out; unsigned char* ws;
};

__device__ __forceinline__ unsigned short f2bf(float f) { unsigned u = __float_as_uint(f); u += 0x7fffu + ((u >> 16) & 1u); return (unsigned short)(u >> 16); }
__device__ __forceinline__ float bf2f(unsigned short b) { return __uint_as_float(((unsigned)b) << 16); }
__device__ __forceinline__ float bflo(unsigned w) { return __uint_as_float(w << 16); }
__device__ __forceinline__ float bfhi(unsigned w) { return __uint_as_float(w & 0xffff0000u); }
typedef __bf16 bf2_t __attribute__((ext_vector_type(2)));
typedef float f32x2 __attribute__((ext_vector_type(2)));
__device__ __forceinline__ unsigned pk(float a, float b) { f32x2 v = {a, b}; return __builtin_bit_cast(unsigned, __builtin_convertvector(v, bf2_t)); }
#define MFMA16(a, b, c) __builtin_amdgcn_mfma_f32_16x16x32_bf16((a), (b), (c), 0, 0, 0)
template <int CTRL> __device__ __forceinline__ float dpp_mov(float v) { return __builtin_bit_cast(float, __builtin_amdgcn_update_dpp(0, __builtin_bit_cast(int, v), CTRL, 0xf, 0xf, true)); }
__device__ __forceinline__ float wave_sum(float v) {
    v += dpp_mov<0xB1>(v);
    v += dpp_mov<0x4E>(v);
    v += dpp_mov<0x141>(v);
    v += dpp_mov<0x140>(v);
    const int iv = __builtin_bit_cast(int, v);
    const float a = __builtin_bit_cast(float, __builtin_amdgcn_readlane(iv, 0)), b = __builtin_bit_cast(float, __builtin_amdgcn_readlane(iv, 16));
    const float c = __builtin_bit_cast(float, __builtin_amdgcn_readlane(iv, 32)), d = __builtin_bit_cast(float, __builtin_amdgcn_readlane(iv, 48));
    return (a + b) + (c + d);
}
__device__ __forceinline__ float silu_f(float v) { return v * __builtin_amdgcn_rcpf(1.0f + __expf(-v)); }
__device__ __forceinline__ float gelu_tanh_f(float v) {
    const float u = 0.7978845608028654f * (v + 0.044715f * v * v * v);
    const float e = __expf(2.0f * u);
    const float t = 1.0f - 2.0f * __builtin_amdgcn_rcpf(e + 1.0f);
    return 0.5f * v * (1.0f + t);
}
__device__ __forceinline__ float rstd_of(const float* ssq, int row) { return __builtin_amdgcn_rsqf(ssq[row] * (1.0f / 1024.0f) + EPS); }

struct EpiGateUp {
    static constexpr bool PERM = true, AFTER_DRAIN = false;
    bf16_t* act; const float* ssq;
    __device__ __forceinline__ void prefetch(const Unit& u, int wr, int wc, int fr, int fq, float (&pre)[8]) const {
        const int row0 = u.pm * 256 + wr * 64 + fr;
#pragma unroll
        for (int i = 0; i < 8; ++i) pre[i] = ssq[row0 + (i >> 2) * 128 + (i & 3) * 16];
    }
    __device__ __forceinline__ void operator()(const f32x4 (&acc)[2][2][4][2], const Unit& u, int wr, int wc, int fr, int fq, const float (&pre)[8]) const {
        const int row0 = u.pm * 256 + wr * 64 + fr, col0 = u.pn * 128 + wc * 32 + 8 * fq;
#pragma unroll
        for (int ai = 0; ai < 2; ++ai)
#pragma unroll
            for (int m = 0; m < 4; ++m) {
                const int row = row0 + ai * 128 + m * 16;
                const float rs = __builtin_amdgcn_rsqf(pre[ai * 4 + m] * (1.0f / 1024.0f) + EPS);
                float o[8], gg[8], ee[8];
                const float nrs = rs * -1.4426950408889634f;
#pragma unroll
                for (int k = 0; k < 8; ++k) ee[k] = acc[ai][0][m][k >> 2][k & 3] * nrs;
#pragma unroll
                for (int k = 0; k < 8; ++k) { ee[k] = __builtin_amdgcn_exp2f(ee[k]); gg[k] = (acc[ai][0][m][k >> 2][k & 3] * rs) * (acc[ai][1][m][k >> 2][k & 3] * rs); }
#pragma unroll
                for (int k = 0; k < 8; ++k) ee[k] = 1.0f + ee[k];
#pragma unroll
                for (int k = 0; k < 8; ++k) ee[k] = __builtin_amdgcn_rcpf(ee[k]);
#pragma unroll
                for (int k = 0; k < 8; ++k) o[k] = gg[k] * ee[k];
                u32x4 w; w.x = pk(o[0], o[1]); w.y = pk(o[2], o[3]); w.z = pk(o[4], o[5]); w.w = pk(o[6], o[7]);
                *(u32x4*)(act + (size_t)row * DFF + col0) = w;
            }
    }
};
template <bool RESF32> struct EpiResid {
    static constexpr bool PERM = true, AFTER_DRAIN = false;
    const float* res; bf16_t* xb; float* ssq; float alpha;
    __device__ __forceinline__ void prefetch(const Unit&, int, int, int, int, float (&)[8]) const {}
    __device__ __forceinline__ void operator()(const f32x4 (&acc)[2][2][4][2], const Unit& u, int wr, int wc, int fr, int fq, const float (&)[8]) const {
        const int row0 = u.pm * 256 + wr * 64 + fr, col0 = u.pn * 256 + wc * 32 + 8 * fq;
        u32x4 rb[2][4][2]; f32x4 rf[RESF32 ? 16 : 1][2];
#pragma unroll
        for (int ai = 0; ai < 2; ++ai)
#pragma unroll
            for (int m = 0; m < 4; ++m)
#pragma unroll
                for (int bj = 0; bj < 2; ++bj) {
                    const size_t off = (size_t)(row0 + ai * 128 + m * 16) * DM + col0 + bj * 128;
                    if constexpr (RESF32) { rf[(ai * 4 + m) * 2 + bj][0] = *(const f32x4*)(res + off); rf[(ai * 4 + m) * 2 + bj][1] = *(const f32x4*)(res + off + 4); }
                    else rb[ai][m][bj] = *(const u32x4*)(xb + off);
                }
        asm volatile("" ::: "memory");
#pragma unroll
        for (int ai = 0; ai < 2; ++ai)
#pragma unroll
            for (int m = 0; m < 4; ++m) {
                const int row = row0 + ai * 128 + m * 16;
                float sq = 0.f;
#pragma unroll
                for (int bj = 0; bj < 2; ++bj) {
                    const size_t off = (size_t)row * DM + col0 + bj * 128;
                    f32x4 r0, r1;
                    if constexpr (RESF32) { r0 = rf[(ai * 4 + m) * 2 + bj][0]; r1 = rf[(ai * 4 + m) * 2 + bj][1]; }
                    else { const u32x4 q = rb[ai][m][bj]; r0 = (f32x4){bflo(q.x), bfhi(q.x), bflo(q.y), bfhi(q.y)}; r1 = (f32x4){bflo(q.z), bfhi(q.z), bflo(q.w), bfhi(q.w)}; }
                    const f32x4 v0 = r0 + acc[ai][bj][m][0] * alpha, v1 = r1 + acc[ai][bj][m][1] * alpha;
                    sq += v0[0] * v0[0] + v0[1] * v0[1] + v0[2] * v0[2] + v0[3] * v0[3] + v1[0] * v1[0] + v1[1] * v1[1] + v1[2] * v1[2] + v1[3] * v1[3];
                    u32x4 w; w.x = pk(v0[0], v0[1]); w.y = pk(v0[2], v0[3]); w.z = pk(v1[0], v1[1]); w.w = pk(v1[2], v1[3]);
                    *(u32x4*)(xb + off) = w;
                }
                sq += __shfl_xor(sq, 16, 64); sq += __shfl_xor(sq, 32, 64);
                if (fq == 0) unsafeAtomicAdd(ssq + row, sq);
            }
    }
};

struct EpiInProj {
    static constexpr bool PERM = true, AFTER_DRAIN = false;
    unsigned char* ws; const float* ssq; const float* a_log; const float* dt_bias;
    __device__ __forceinline__ void prefetch(const Unit& u, int wr, int wc, int fr, int fq, float (&pre)[8]) const {
        const int row0 = u.pm * 256 + wr * 64 + fr;
#pragma unroll
        for (int i = 0; i < 8; ++i) pre[i] = ssq[row0 + (i >> 2) * 128 + (i & 3) * 16];
    }
    __device__ __forceinline__ void operator()(const f32x4 (&acc)[2][2][4][2], const Unit& u, int wr, int wc, int fr, int fq, const float (&pre)[8]) const {
        const int row0 = u.pm * 256 + wr * 64 + fr, pn = u.pn;
        if (pn < 12) {
            bf16_t* base; int ld, colt, mode;
            if (pn < 2) { base = (bf16_t*)(ws + WS_U); ld = 512; colt = pn * 256; mode = 1; }
            else if (pn < 4) { base = (bf16_t*)(ws + WS_V); ld = 512; colt = (pn - 2) * 256; mode = 1; }
            else if (pn < 10) { base = (bf16_t*)(ws + WS_QKV); ld = 1536; colt = (pn - 4) * 256; mode = 0; }
            else { base = (bf16_t*)(ws + WS_Z); ld = 512; colt = (pn - 10) * 256; mode = 2; }
            const int col0 = colt + wc * 32 + 8 * fq;
#pragma unroll
            for (int ai = 0; ai < 2; ++ai)
#pragma unroll
                for (int m = 0; m < 4; ++m) {
                    const int row = row0 + ai * 128 + m * 16;
                    const float rs = __builtin_amdgcn_rsqf(pre[ai * 4 + m] * (1.0f / 1024.0f) + EPS);
#pragma unroll
                    for (int bj = 0; bj < 2; ++bj) {
                        float o[8];
#pragma unroll
                        for (int k = 0; k < 8; ++k) o[k] = acc[ai][bj][m][k >> 2][k & 3] * rs;
                        if (mode != 0) {
                            float ee[8];
#pragma unroll
                            for (int k = 0; k < 8; ++k) { const float v = o[k]; const float a = (mode == 1) ? 1.5957691216057308f * (v + 0.044715f * v * v * v) : v; ee[k] = a * -1.4426950408889634f; }
#pragma unroll
                            for (int k = 0; k < 8; ++k) ee[k] = __builtin_amdgcn_exp2f(ee[k]);
#pragma unroll
                            for (int k = 0; k < 8; ++k) ee[k] = 1.0f + ee[k];
#pragma unroll
                            for (int k = 0; k < 8; ++k) ee[k] = __builtin_amdgcn_rcpf(ee[k]);
#pragma unroll
                            for (int k = 0; k < 8; ++k) o[k] = o[k] * ee[k];
                        }
                        u32x4 w; w.x = pk(o[0], o[1]); w.y = pk(o[2], o[3]); w.z = pk(o[4], o[5]); w.w = pk(o[6], o[7]);
                        *(u32x4*)(base + (size_t)row * ld + col0 + bj * 128) = w;
                    }
                }
        } else if (wc == 0 && fq == 0) {
            float* BA = (float*)(ws + WS_BA);
            const f32x4 al = *(const f32x4*)a_log, db = *(const f32x4*)dt_bias;
#pragma unroll
            for (int ai = 0; ai < 2; ++ai)
#pragma unroll
                for (int m = 0; m < 4; ++m) {
                    const int row = row0 + ai * 128 + m * 16;
                    const float rs = __builtin_amdgcn_rsqf(pre[ai * 4 + m] * (1.0f / 1024.0f) + EPS);
                    f32x4 be, gg;
#pragma unroll
                    for (int j = 0; j < 4; ++j) {
                        const float bv = acc[ai][0][m][0][j] * rs, av = acc[ai][0][m][1][j] * rs + db[j];
                        be[j] = 1.0f / (1.0f + __expf(-bv));
                        const float sp = fmaxf(av, 0.f) + log1pf(__expf(-fabsf(av)));
                        gg[j] = -__expf(al[j]) * sp;
                    }
                    *(f32x4*)(BA + (size_t)row * 8) = be; *(f32x4*)(BA + (size_t)row * 8 + 4) = gg;
                }
        }
    }
};

#ifndef DNP_S1
#define DNP_S1 1
#endif
#ifndef DNP_S3
#define DNP_S3 1
#endif
#ifndef DNP_S4
#define DNP_S4 1
#endif
#ifndef DNP_S5
#define DNP_S5 1
#endif
constexpr int KS = 136;
constexpr int DN_ITEM = 36864;
constexpr int SLOT_BYTES = 69376;

template <int I, int HALF> __device__ __forceinline__ void sol_load_row(f32x4 (&l)[16], const float* Lm, float dep) {
    constexpr int SPLIT = 5, NJ = (I + 3) / 4, LO = HALF ? SPLIT : 0, HI = HALF ? NJ : (NJ < SPLIT ? NJ : SPLIT);
    if constexpr (LO < HI) {
        int z; asm volatile("v_and_b32 %0, 0, %1" : "=v"(z) : "v"(dep));
        const f32x4* Lr = (const f32x4*)(Lm + I * 64 + z);
#pragma unroll
        for (int j4 = LO; j4 < HI; ++j4) l[j4] = Lr[j4];
    }
}
template <int I> __device__ __forceinline__ float sol_fma_row(const f32x4 (&l)[16], const float (&x)[64], float rhs) {
    float r0 = rhs, r1 = 0.f;
#pragma unroll
    for (int j4 = 0; j4 * 4 < I; ++j4) {
#pragma unroll
        for (int e = 0; e < 4; ++e) if (j4 * 4 + e < I) { if (j4 & 1) r1 -= l[j4][e] * x[j4 * 4 + e]; else r0 -= l[j4][e] * x[j4 * 4 + e]; }
    }
    return r0 + r1;
}
template <int I> struct SolRows {
    static __device__ __forceinline__ void run(f32x4 (&la)[16], f32x4 (&lb)[16], float (&x)[64], const float* Lm, const bf16_t* srcb, const float* scl, float rhs) {
        sol_load_row<I, 1>(la, Lm, I > 0 ? x[I - 1] : 0.f);
        float rhs_next = 0.f;
        if constexpr (I + 1 < 64) {
            sol_load_row<I + 1, 0>(lb, Lm, I > 0 ? x[I - 1] : 0.f);
            int z; asm volatile("v_and_b32 %0, 0, %1" : "=v"(z) : "v"(I > 0 ? x[I - 1] : 0.f));
            rhs_next = bf2f(srcb[(I + 1) * 136 + z]) * scl[I + 1 + z];
        }
        x[I] = sol_fma_row<I>(la, x, rhs);
        if constexpr (I + 1 < 64) SolRows<I + 1>::run(lb, la, x, Lm, srcb, scl, rhs_next);
    }
};
#define DNP_LANE_VARS \
    const int tid = otid(), slot = tid >> 8, ts = tid & 255, sw = ts >> 6, lane = tid & 63, fr = lane & 15, fq = lane >> 4; \
    unsigned char* sb = shm + slot * SLOT_BYTES; \
    bf16_t* kb = (bf16_t*)sb; bf16_t* qb = (bf16_t*)(sb + 17408); bf16_t* vb = (bf16_t*)(sb + 34816); \
    float* Lm = (float*)(sb + 52224); float* gcs = (float*)(sb + 68608); float* bts = (float*)(sb + 68864); float* bes = (float*)(sb + 69120); \
    (void)ts; (void)sw; (void)lane; (void)fr; (void)fq; (void)kb; (void)qb; (void)vb; (void)Lm; (void)gcs; (void)bts; (void)bes;
__device__ __forceinline__ void phase_dnpre(const Params& p, unsigned char* shm) {
    unsigned char* ws = p.ws;
    const int slot0 = otid() >> 8;
    const bf16_t* QKV = (const bf16_t*)(ws + WS_QKV); const float* BA = (const float*)(ws + WS_BA);
    bf16_t* DN = (bf16_t*)(ws + WS_DN); float* GL = (float*)(ws + WS_GL);
    unsigned xr[16][3], xmr[3][3]; float ba_b = 0.f, ba_g = 0.f;
    auto dnp_issue = [&](int it0n) {
        DNP_LANE_VARS
        const int itemn = it0n + slot0, bhn = itemn >> 5, nn = itemn & 31, bn = bhn >> 2, hn = bhn & 3;
        const int row0n = bn * 2048 + nn * 64, cq = hn * 128 + 2 * lane, tt0 = sw * 16;
#pragma unroll
        for (int i = 0; i < 16; ++i)
#pragma unroll
            for (int s2 = 0; s2 < 3; ++s2) xr[i][s2] = *(const unsigned*)(QKV + (size_t)(row0n + tt0 + i) * 1536 + s2 * 512 + cq);
#pragma unroll
        for (int r = 0; r < 3; ++r) {
            const int pos = nn * 64 + tt0 - 3 + r;
#pragma unroll
            for (int s2 = 0; s2 < 3; ++s2) { xmr[r][s2] = 0u; if (pos >= 0) xmr[r][s2] = *(const unsigned*)(QKV + (size_t)(bn * 2048 + pos) * 1536 + s2 * 512 + cq); }
        }
        if (sw == 0) { ba_b = BA[(size_t)(row0n + lane) * 8 + hn]; ba_g = BA[(size_t)(row0n + lane) * 8 + 4 + hn]; }
    };
    dnp_issue(blockIdx.x * 2);
    for (int it0 = blockIdx.x * 2; it0 < 4096; it0 += gridDim.x * 2) {
        const int item = it0 + slot0, bh = item >> 5, n = item & 31, b = bh >> 2, h = bh & 3;
        const int row0 = b * 2048 + n * 64;
        bf16_t* Dg = DN + (size_t)item * DN_ITEM; bf16_t* Wg = Dg; bf16_t* Qdg = Dg + 8192; bf16_t* KdTg = Dg + 16384; bf16_t* UTg = Dg + 24576; bf16_t* QKg = Dg + 32768;
        (void)row0; (void)n; (void)b;
        float cur_b, cur_g;
#if DNP_S1
        {
            DNP_LANE_VARS
            const int cq = h * 128 + 2 * lane;
            float w[4][6];
#pragma unroll
            for (int j = 0; j < 4; ++j)
#pragma unroll
                for (int s = 0; s < 3; ++s) { const f32x2 t = *(const f32x2*)(p.conv_w + j * 1536 + s * 512 + cq); w[j][2 * s] = t.x; w[j][2 * s + 1] = t.y; }
            float xm[3][6];
            const int tt0 = sw * 16;
#pragma unroll
            for (int r = 0; r < 3; ++r)
#pragma unroll
                for (int s = 0; s < 3; ++s) { xm[r][2 * s] = bflo(xmr[r][s]); xm[r][2 * s + 1] = bfhi(xmr[r][s]); }
            cur_b = ba_b; cur_g = ba_g;
#pragma unroll
            for (int i = 0; i < 16; ++i) {
                float x0[6], y[6];
#pragma unroll
                for (int s = 0; s < 3; ++s) { const unsigned v = xr[i][s]; x0[2 * s] = bflo(v); x0[2 * s + 1] = bfhi(v); }
#pragma unroll
                for (int c = 0; c < 6; ++c) { const float t = w[0][c] * xm[0][c] + w[1][c] * xm[1][c] + w[2][c] * xm[2][c] + w[3][c] * x0[c]; y[c] = silu_f(t); }
                const float sq = wave_sum(y[0] * y[0] + y[1] * y[1]), sk = wave_sum(y[2] * y[2] + y[3] * y[3]);
                const float rq = __builtin_amdgcn_rsqf(sq + EPS) * 0.08838834764831845f, rk = __builtin_amdgcn_rsqf(sk + EPS);
                *(unsigned*)(qb + (tt0 + i) * KS + 2 * lane) = pk(y[0] * rq, y[1] * rq);
                *(unsigned*)(kb + (tt0 + i) * KS + 2 * lane) = pk(y[2] * rk, y[3] * rk);
                *(unsigned*)(vb + (tt0 + i) * KS + 2 * lane) = pk(y[4], y[5]);
#pragma unroll
                for (int c = 0; c < 6; ++c) { xm[0][c] = xm[1][c]; xm[1][c] = xm[2][c]; xm[2][c] = x0[c]; }
            }
        }
        asm volatile("" ::: "memory");
        if (it0 + (int)gridDim.x * 2 < 4096) dnp_issue(it0 + (int)gridDim.x * 2);
        asm volatile("" ::: "memory");
#endif
        { DNP_LANE_VARS
        if (sw == 0) {
            const float beta = cur_b; float g = cur_g;
#pragma unroll
            for (int o = 1; o < 64; o <<= 1) { const float t = __shfl_up(g, o, 64); if (lane >= o) g += t; }
            gcs[lane] = g; bts[lane] = beta; bes[lane] = beta * __expf(g);
        } }
        __syncthreads();
#if DNP_S3
        {
            DNP_LANE_VARS
            bf16x8 ak[4], aq[4];
#pragma unroll
            for (int kk = 0; kk < 4; ++kk) { ak[kk] = *(const bf16x8*)(kb + (16 * sw + fr) * KS + 32 * kk + 8 * fq); aq[kk] = *(const bf16x8*)(qb + (16 * sw + fr) * KS + 32 * kk + 8 * fq); }
            float gci[4], bi[4];
#pragma unroll
            for (int r = 0; r < 4; ++r) { gci[r] = gcs[16 * sw + 4 * fq + r]; bi[r] = bts[16 * sw + 4 * fq + r]; }
#pragma unroll
            for (int jt = 0; jt < 4; ++jt) {
                if (jt <= sw) {
                    f32x4 dk = {0.f, 0.f, 0.f, 0.f}, dq = {0.f, 0.f, 0.f, 0.f};
#pragma unroll
                    for (int kk = 0; kk < 4; ++kk) { const bf16x8 bb = *(const bf16x8*)(kb + (16 * jt + fr) * KS + 32 * kk + 8 * fq); dk = MFMA16(ak[kk], bb, dk); dq = MFMA16(aq[kk], bb, dq); }
                    const int j = 16 * jt + fr; const float gcj = gcs[j];
#pragma unroll
                    for (int r = 0; r < 4; ++r) {
                        const int i = 16 * sw + 4 * fq + r; const float dec = __expf(gci[r] - gcj);
                        Lm[((i >> 1) * 64 + j) * 2 + (i & 1)] = (i > j) ? bi[r] * dk[r] * dec : 0.f;
                        const float qv = (i >= j) ? dq[r] * dec : 0.f;
                        QKg[i * 64 + j] = (bf16_t)(pk(qv, 0.f) & 0xffffu);
                    }
                } else {
#pragma unroll
                    for (int r = 0; r < 4; ++r) QKg[(16 * sw + 4 * fq + r) * 64 + 16 * jt + fr] = (bf16_t)0;
                }
            }
        }
#endif
        __syncthreads();
#if DNP_S5
        {
            DNP_LANE_VARS
            const float gl_last = gcs[63];
#pragma unroll
            for (int rep = 0; rep < 4; ++rep) {
                const int chunk = ts + 256 * rep, i = chunk >> 4, d0 = (chunk & 15) * 8;
                const u32x4 v = *(const u32x4*)(qb + i * KS + d0); const float s = __expf(gcs[i]);
                u32x4 w; w.x = pk(bflo(v.x) * s, bfhi(v.x) * s); w.y = pk(bflo(v.y) * s, bfhi(v.y) * s); w.z = pk(bflo(v.z) * s, bfhi(v.z) * s); w.w = pk(bflo(v.w) * s, bfhi(v.w) * s);
                *(u32x4*)(Qdg + i * 128 + d0) = w;
            }
            const int d = ts & 127, half = ts >> 7;
#pragma unroll
            for (int i8 = 0; i8 < 4; ++i8) {
                float o[8];
#pragma unroll
                for (int e = 0; e < 8; ++e) { const int i = 32 * half + 8 * i8 + e; o[e] = bf2f(kb[i * KS + d]) * __expf(gl_last - gcs[i]); }
                u32x4 w; w.x = pk(o[0], o[1]); w.y = pk(o[2], o[3]); w.z = pk(o[4], o[5]); w.w = pk(o[6], o[7]);
                *(u32x4*)(KdTg + d * 64 + 32 * half + 8 * i8) = w;
            }
            if (ts == 0) GL[item] = __expf(gl_last);
        }
#endif
#if DNP_S4
        {
            DNP_LANE_VARS
            const bool isU = ts < 128; const bf16_t* srcb = isU ? vb : kb; const float* scl = isU ? bts : bes; const int cc = ts & 127;
            float x[64];
            {
                const bf16_t* sc = srcb + cc;
                f32x4 lb[2][4], lt[2][3]; float rh[2][4];
                int zt = 0, k = 0;
                auto opaque0 = [](float v) { int z; asm volatile("v_and_b32 %0, 0, %1" : "=v"(z) : "v"(v)); return z; };
                auto fnma2 = [](f32x2 l, float xv, f32x2 a) { return __builtin_elementwise_fma(-l, (f32x2){xv, xv}, a); };
                auto ld_group = [&](int pp, int c, int slot, int z) {
                    const float* a = Lm + ((2 * pp) * 64 + 4 * c) * 2 + z; const float* b = Lm + ((2 * pp + 1) * 64 + 4 * c) * 2 + z;
                    lb[slot][0] = *(const f32x4*)a; lb[slot][1] = *(const f32x4*)(a + 4); lb[slot][2] = *(const f32x4*)b; lb[slot][3] = *(const f32x4*)(b + 4);
                };
                auto ld_misc = [&](int pp, int z) {
                    lt[pp & 1][0] = *(const f32x4*)(Lm + ((2 * pp) * 64 + 4 * pp) * 2 + z);
                    lt[pp & 1][1] = *(const f32x4*)(Lm + ((2 * pp + 1) * 64 + 4 * pp) * 2 + z);
                    lt[pp & 1][2] = *(const f32x4*)(Lm + ((2 * pp + 1) * 64 + 4 * pp) * 2 + 4 + z);
                    const f32x4 s4 = *(const f32x4*)(scl + 4 * pp + z);
#pragma unroll
                    for (int r = 0; r < 4; ++r) rh[pp & 1][r] = bf2f(sc[(4 * pp + r) * KS + z]) * s4[r];
                };
                ld_misc(0, 0);
                ld_group(1, 0, 0, 0);
#pragma unroll
                for (int pp = 0; pp < 16; ++pp) {
                    f32x2 accA = {rh[pp & 1][0], rh[pp & 1][1]}, accB = {rh[pp & 1][2], rh[pp & 1][3]};
                    if (pp + 1 < 16) ld_misc(pp + 1, zt);
#pragma unroll
                    for (int c = 0; c < pp; ++c) {
                        const int np = (c + 1 < pp) ? pp : pp + 1, nc = (c + 1 < pp) ? c + 1 : 0;
                        if (np < 16) ld_group(np, nc, (k + 1) & 1, zt);
                        const f32x4 l0 = lb[k & 1][0], l1 = lb[k & 1][1], l2 = lb[k & 1][2], l3 = lb[k & 1][3];
                        accA = fnma2((f32x2){l0[0], l0[1]}, x[4 * c], accA); accB = fnma2((f32x2){l2[0], l2[1]}, x[4 * c], accB);
                        accA = fnma2((f32x2){l0[2], l0[3]}, x[4 * c + 1], accA); accB = fnma2((f32x2){l2[2], l2[3]}, x[4 * c + 1], accB);
                        accA = fnma2((f32x2){l1[0], l1[1]}, x[4 * c + 2], accA); accB = fnma2((f32x2){l3[0], l3[1]}, x[4 * c + 2], accB);
                        accA = fnma2((f32x2){l1[2], l1[3]}, x[4 * c + 3], accA); accB = fnma2((f32x2){l3[2], l3[3]}, x[4 * c + 3], accB);
                        zt = opaque0(accA[0]);
                        ++k;
                    }
                    const f32x4 tA = lt[pp & 1][0], tB0 = lt[pp & 1][1], tB1 = lt[pp & 1][2];
                    const float x0 = accA[0], x1 = accA[1] - tA[1] * x0;
                    accB = fnma2((f32x2){tB0[0], tB0[1]}, x0, accB); accB = fnma2((f32x2){tB0[2], tB0[3]}, x1, accB);
                    const float x2 = accB[0], x3 = accB[1] - tB1[1] * x2;
                    x[4 * pp] = x0; x[4 * pp + 1] = x1; x[4 * pp + 2] = x2; x[4 * pp + 3] = x3;
                }
            }
            if (isU) {
#pragma unroll
                for (int i8 = 0; i8 < 8; ++i8) { u32x4 w; w.x = pk(x[8 * i8], x[8 * i8 + 1]); w.y = pk(x[8 * i8 + 2], x[8 * i8 + 3]); w.z = pk(x[8 * i8 + 4], x[8 * i8 + 5]); w.w = pk(x[8 * i8 + 6], x[8 * i8 + 7]);
                    *(u32x4*)(UTg + cc * 64 + 8 * i8) = w; }
            } else {
#pragma unroll
                for (int i = 0; i < 64; ++i) Wg[i * 128 + cc] = (bf16_t)(pk(x[i], 0.f) & 0xffffu);
            }
        }
#endif
        __syncthreads();
    }
}

__device__ __forceinline__ bf16x8 ldfrag_perm(const bf16_t* rp, int fq) {
    const u32x2 lo = *(const u32x2*)(rp + 4 * fq), hi = *(const u32x2*)(rp + 16 + 4 * fq);
    u32x4 w; w.x = lo.x; w.y = lo.y; w.z = hi.x; w.w = hi.y; return __builtin_bit_cast(bf16x8, w);
}
__device__ __forceinline__ bf16x8 pack2(const f32x4 a, const f32x4 b) { u32x4 w; w.x = pk(a[0], a[1]); w.y = pk(a[2], a[3]); w.z = pk(b[0], b[1]); w.w = pk(b[2], b[3]); return __builtin_bit_cast(bf16x8, w); }
__device__ __forceinline__ bf16x8 ldfrag_lds(const unsigned char* rp, int fq) {
    return *(const bf16x8*)(rp + 16 * fq);
}
constexpr int SC_W = 0, SC_QD = 17408, SC_KDT = 34816, SC_QK = 55296, SC_BUF = 64512, SC_OB = 2 * SC_BUF, ST_W = 272, ST_K = 160, ST_Q = 144, OBS = 128;
__device__ __forceinline__ void scan_bh(const Params& p, unsigned char* shm, int bh) {
    unsigned char* ws = p.ws;
    const int tid = otid(), wid = tid >> 6, lane = tid & 63, fr = lane & 15, fq = lane >> 4;
    const int b = bh >> 2, h = bh & 3, e0 = wid * 16;
    float* ob = (float*)(shm + SC_OB);
    const bf16_t* DN = (const bf16_t*)(ws + WS_DN); const float* GL = (const float*)(ws + WS_GL); const bf16_t* Zb = (const bf16_t*)(ws + WS_Z); bf16_t* MIX = (bf16_t*)(ws + WS_MIX);
    const int ec = tid >> 3, ee = (tid & 7) * 16;
    f32x4 dnw[4];
#pragma unroll
    for (int i = 0; i < 4; ++i) dnw[i] = *(const f32x4*)(p.dn_norm + ee + 4 * i);
    int soff[7], goff[7];
    auto pieceoff = [](int m) { return (m < 2) ? 32 * m : 32 * (m - 2) + 8; };
#pragma unroll
    for (int i = 0; i < 4; ++i) { const int chunk = tid + 512 * i, c1 = chunk & 1023, c16 = c1 & 15; goff[i] = chunk * 8; soff[i] = (i < 2 ? SC_W : SC_QD) + (c1 >> 4) * ST_W + (c16 >> 2) * 64 + pieceoff(c16 & 3); }
#pragma unroll
    for (int i = 4; i < 6; ++i) { const int c1 = tid + 512 * (i - 4), c8 = c1 & 7; goff[i] = 16384 + c1 * 8; soff[i] = SC_KDT + (c1 >> 3) * ST_K + (c8 >> 2) * 64 + pieceoff(c8 & 3); }
    { const int c8 = tid & 7; goff[6] = 32768 + tid * 8; soff[6] = SC_QK + (tid >> 3) * ST_Q + (c8 >> 2) * 64 + pieceoff(c8 & 3); }
    f32x4 S[8];
#pragma unroll
    for (int i = 0; i < 8; ++i) S[i] = (f32x4){0.f, 0.f, 0.f, 0.f};
    u32x4 st[7]; u32x2 ut[4]; float gl;
    {
        const bf16_t* Dg = DN + (size_t)(bh * 32) * DN_ITEM;
#pragma unroll
        for (int i = 0; i < 7; ++i) st[i] = *(const u32x4*)(Dg + goff[i]);
#pragma unroll
        for (int ct = 0; ct < 4; ++ct) ut[ct] = *(const u32x2*)(Dg + 24576 + (e0 + fr) * 64 + 16 * ct + 4 * fq);
        gl = GL[bh * 32];
#pragma unroll
        for (int i = 0; i < 7; ++i) { *(u32x2*)(shm + soff[i]) = (u32x2){st[i].x, st[i].y}; *(u32x2*)(shm + soff[i] + 16) = (u32x2){st[i].z, st[i].w}; }
        const bf16_t* D1 = DN + (size_t)(bh * 32 + 1) * DN_ITEM;
#pragma unroll
        for (int i = 0; i < 7; ++i) st[i] = *(const u32x4*)(D1 + goff[i]);
    }
    __syncthreads();
    u32x4 zn0, zn1;
    { const size_t r0z = (size_t)b * 2048 + ec; zn0 = *(const u32x4*)(Zb + r0z * 512 + h * 128 + ee); zn1 = *(const u32x4*)(Zb + r0z * 512 + h * 128 + ee + 8); }
    for (int n = 0; n < 32; ++n) {
        const unsigned char* buf = shm + (n & 1) * SC_BUF;
        u32x2 utc[4]; const float glc = gl;
#pragma unroll
        for (int ct = 0; ct < 4; ++ct) utc[ct] = ut[ct];
        const size_t row = (size_t)b * 2048 + n * 64 + ec;
        const u32x4 z0 = zn0, z1 = zn1;
        if (n + 1 < 32) {
            const bf16_t* Dg = DN + (size_t)(bh * 32 + n + 1) * DN_ITEM;
#pragma unroll
            for (int ct = 0; ct < 4; ++ct) ut[ct] = *(const u32x2*)(Dg + 24576 + (e0 + fr) * 64 + 16 * ct + 4 * fq);
            gl = GL[bh * 32 + n + 1];
        }
        bf16x8 SB[4];
#pragma unroll
        for (int kb = 0; kb < 4; ++kb) SB[kb] = pack2(S[2 * kb], S[2 * kb + 1]);
        f32x4 Vn[4], O[4];
#pragma unroll
        for (int ct = 0; ct < 4; ++ct) {
            f32x4 P = {0.f, 0.f, 0.f, 0.f}, Oq = {0.f, 0.f, 0.f, 0.f};
            const unsigned char* wrp = buf + SC_W + (16 * ct + fr) * ST_W; const unsigned char* qrp = buf + SC_QD + (16 * ct + fr) * ST_W;
#pragma unroll
            for (int kb = 0; kb < 4; ++kb) { P = MFMA16(ldfrag_lds(wrp + 64 * kb, fq), SB[kb], P); Oq = MFMA16(ldfrag_lds(qrp + 64 * kb, fq), SB[kb], Oq); }
            const u32x2 uu = utc[ct];
            Vn[ct] = (f32x4){bflo(uu.x) - P[0], bfhi(uu.x) - P[1], bflo(uu.y) - P[2], bfhi(uu.y) - P[3]}; O[ct] = Oq;
        }
        bf16x8 VB[2]; VB[0] = pack2(Vn[0], Vn[1]); VB[1] = pack2(Vn[2], Vn[3]);
#pragma unroll
        for (int ct = 0; ct < 4; ++ct)
#pragma unroll
            for (int kc = 0; kc < 2; ++kc) O[ct] = MFMA16(ldfrag_lds(buf + SC_QK + (16 * ct + fr) * ST_Q + 64 * kc, fq), VB[kc], O[ct]);
#pragma unroll
        for (int dt = 0; dt < 8; ++dt) {
            f32x4 a = S[dt] * glc;
#pragma unroll
            for (int kc = 0; kc < 2; ++kc) a = MFMA16(ldfrag_lds(buf + SC_KDT + (16 * dt + fr) * ST_K + 64 * kc, fq), VB[kc], a);
            S[dt] = a;
        }
#pragma unroll
        for (int ct = 0; ct < 4; ++ct)
#pragma unroll
            for (int r = 0; r < 4; ++r) ob[(16 * ct + 4 * fq + r) * OBS + e0 + fr] = O[ct][r];
        if (n + 1 < 32) {
            unsigned char* nb = shm + ((n + 1) & 1) * SC_BUF;
#pragma unroll
            for (int i = 0; i < 7; ++i) { *(u32x2*)(nb + soff[i]) = (u32x2){st[i].x, st[i].y}; *(u32x2*)(nb + soff[i] + 16) = (u32x2){st[i].z, st[i].w}; }
        }
        if (n + 2 < 32) {
            const bf16_t* D2 = DN + (size_t)(bh * 32 + n + 2) * DN_ITEM;
#pragma unroll
            for (int i = 0; i < 7; ++i) st[i] = *(const u32x4*)(D2 + goff[i]);
        }
        __syncthreads();
        {
            f32x4 o4[4]; float ss = 0.f;
#pragma unroll
            for (int i = 0; i < 4; ++i) { o4[i] = *(const f32x4*)(ob + ec * OBS + ee + 4 * i); ss += o4[i][0] * o4[i][0] + o4[i][1] * o4[i][1] + o4[i][2] * o4[i][2] + o4[i][3] * o4[i][3]; }
            ss += __shfl_xor(ss, 1, 64); ss += __shfl_xor(ss, 2, 64); ss += __shfl_xor(ss, 4, 64);
            const float rs = __builtin_amdgcn_rsqf(ss * (1.0f / 128.0f) + EPS);
            const unsigned zz[8] = {z0.x, z0.y, z0.z, z0.w, z1.x, z1.y, z1.z, z1.w};
            unsigned ow[8];
#pragma unroll
            for (int i = 0; i < 4; ++i) {
                const f32x4 v = o4[i] * rs * dnw[i];
                ow[2 * i] = pk(v[0] * bflo(zz[2 * i]), v[1] * bfhi(zz[2 * i])); ow[2 * i + 1] = pk(v[2] * bflo(zz[2 * i + 1]), v[3] * bfhi(zz[2 * i + 1]));
            }
            u32x4 w0, w1; w0.x = ow[0]; w0.y = ow[1]; w0.z = ow[2]; w0.w = ow[3]; w1.x = ow[4]; w1.y = ow[5]; w1.z = ow[6]; w1.w = ow[7];
            *(u32x4*)(MIX + row * 1024 + 512 + h * 128 + ee) = w0; *(u32x4*)(MIX + row * 1024 + 512 + h * 128 + ee + 8) = w1;
        }
        if (n + 1 < 32) { const size_t rz = (size_t)b * 2048 + (n + 1) * 64 + ec; zn0 = *(const u32x4*)(Zb + rz * 512 + h * 128 + ee); zn1 = *(const u32x4*)(Zb + rz * 512 + h * 128 + ee + 8); }
        __syncthreads();
    }
}

__device__ __forceinline__ void sg_item(const Params& p, unsigned char* shm, int item) {
    unsigned char* ws = p.ws;
    const int tid = otid(), wid = tid >> 6, lane = tid & 63, fr = lane & 15, fq = lane >> 4;
    const int r0 = item * 128;
    bf16_t* vT = (bf16_t*)shm;
    const bf16_t* Vg = (const bf16_t*)(ws + WS_V); const bf16_t* Ug = (const bf16_t*)(ws + WS_U); const bf16_t* Wc = (const bf16_t*)(ws + WS_WC); bf16_t* MIX = (bf16_t*)(ws + WS_MIX);
    float lg[8], lb[8];
#pragma unroll
    for (int j = 0; j < 8; ++j) { lg[j] = p.sg_ln_g[lane + 64 * j]; lb[j] = p.sg_ln_b[lane + 64 * j]; }
    for (int ip = 0; ip < 8; ++ip) {
        const int s = wid * 16 + 2 * ip;
        float a0[8], a1[8]; float s0 = 0.f, s1 = 0.f;
#pragma unroll
        for (int j = 0; j < 8; ++j) { a0[j] = bf2f(Vg[(size_t)(r0 + s) * 512 + lane + 64 * j]); a1[j] = bf2f(Vg[(size_t)(r0 + s + 1) * 512 + lane + 64 * j]); s0 += a0[j]; s1 += a1[j]; }
        const float m0 = wave_sum(s0) * (1.0f / 512.0f), m1 = wave_sum(s1) * (1.0f / 512.0f);
        float q0 = 0.f, q1 = 0.f;
#pragma unroll
        for (int j = 0; j < 8; ++j) { a0[j] -= m0; a1[j] -= m1; q0 += a0[j] * a0[j]; q1 += a1[j] * a1[j]; }
        const float rs0 = __builtin_amdgcn_rsqf(wave_sum(q0) * (1.0f / 512.0f) + EPS), rs1 = __builtin_amdgcn_rsqf(wave_sum(q1) * (1.0f / 512.0f) + EPS);
#pragma unroll
        for (int j = 0; j < 8; ++j) *(unsigned*)(vT + (lane + 64 * j) * KS + s) = pk(a0[j] * rs0 * lg[j] + lb[j], a1[j] * rs1 * lg[j] + lb[j]);
    }
    __syncthreads();
    const int g = wid, cg0 = g * 64;
    for (int mt = 0; mt < 8; ++mt) {
        f32x4 acc[4];
#pragma unroll
        for (int nt = 0; nt < 4; ++nt) acc[nt] = (f32x4){0.f, 0.f, 0.f, 0.f};
#pragma unroll
        for (int ks = 0; ks < 4; ++ks) {
            if (32 * ks <= 16 * mt + 15) {
                const bf16x8 wf = *(const bf16x8*)(Wc + (size_t)(g * 128 + 16 * mt + fr) * 128 + 32 * ks + 8 * fq);
#pragma unroll
                for (int nt = 0; nt < 4; ++nt) { const bf16x8 vf = *(const bf16x8*)(vT + (cg0 + 16 * nt + fr) * KS + 32 * ks + 8 * fq); acc[nt] = MFMA16(vf, wf, acc[nt]); }
            }
        }
        const int t = 16 * mt + fr; const size_t row = (size_t)r0 + t; const float bs = p.sg_b[g * 128 + t];
#pragma unroll
        for (int nt = 0; nt < 4; ++nt) {
            const int cbase = cg0 + 16 * nt + 4 * fq;
            const u32x2 uu = *(const u32x2*)(Ug + row * 512 + cbase);
            u32x2 w; w.x = pk(bflo(uu.x) * (acc[nt][0] + bs), bfhi(uu.x) * (acc[nt][1] + bs)); w.y = pk(bflo(uu.y) * (acc[nt][2] + bs), bfhi(uu.y) * (acc[nt][3] + bs));
            *(u32x2*)(MIX + row * 1024 + cbase) = w;
        }
    }
    __syncthreads();
}
__device__ __forceinline__ void phase_scan_sg(const Params& p, unsigned char* shm) {
    if (blockIdx.x < 128) scan_bh(p, shm, blockIdx.x);
    else for (int it = blockIdx.x - 128; it < 512; it += gridDim.x - 128) sg_item(p, shm, it);
}

struct PrepEnt { const float* src; bf16_t* dst; const float* scale; int K, N, NP, blk, bs, boff, start, pad; };
#define PREP_DECODE(tix_, src_, dst_, scale_, K_, N_, blk_, bs_, boff_, tk_, tn_) do { \
    const int tq = (tix_); const int jt = (tq >= 704) + (tq >= 1408) + (tq >= 2112) + (tq >= 2944) + (tq >= 3200) + (tq >= 3904) + (tq >= 4608); \
    const PrepEnt* en = ptab + jt; src_ = en->src; dst_ = en->dst; scale_ = en->scale; K_ = en->K; N_ = en->N; blk_ = en->blk; bs_ = en->bs; boff_ = en->boff; \
    const int j = tq - en->start, ntn = en->NP / 64; tk_ = j / ntn; tn_ = j % ntn; } while (0)
__device__ __forceinline__ void prep_load(const float* __restrict__ src, const float* __restrict__ scale, int N, int tk, int tn, int t, float (&v)[8]) {
    const int nl = t & 63, n = tn * 64 + nl;
#pragma unroll
    for (int i = 0; i < 8; ++i) { const int kk = (t >> 6) + 8 * i, k = tk * 64 + kk; float a = (n < N) ? src[(size_t)k * N + n] : 0.f; if (scale) a *= scale[k]; v[i] = a; }
}
__device__ __forceinline__ void prep_emit(bf16_t* __restrict__ dst, int K, int blk, int bs, int boff, int tk, int tn, int t, const float (&v)[8], float* tile) {
    const int nl = t & 63;
#pragma unroll
    for (int i = 0; i < 8; ++i) tile[((t >> 6) + 8 * i) * 65 + nl] = v[i];
    __syncthreads();
    const int nn = t >> 3, kg = t & 7, nrow = tn * 64 + nn, drow = (nrow / blk) * bs + (nrow % blk) + boff;
    float o[8];
#pragma unroll
    for (int j = 0; j < 8; ++j) o[j] = tile[(kg * 8 + j) * 65 + nn];
    u32x4 w; w.x = pk(o[0], o[1]); w.y = pk(o[2], o[3]); w.z = pk(o[4], o[5]); w.w = pk(o[6], o[7]);
    *(u32x4*)(dst + ((size_t)(drow >> 8) * (K >> 6) + tk) * 16384 + (drow & 255) * 64 + kg * 8) = w;
}
__device__ __forceinline__ void phase_prep(const Params& p, float* tiles) {
    unsigned char* ws = p.ws;
    {
        const int t = otid(); int tix = blockIdx.x, par = 0;
        PrepEnt* ptab = (PrepEnt*)(tiles + 2 * 64 * 65);
        if (t == 0) {
            constexpr int BIG = 1 << 30;
            ptab[0] = PrepEnt{p.ffn1_wg, (bf16_t*)(ws + WS_BT1), p.ffn1_norm, 1024, 2816, 2816, 128, 256, 0, 0, 0};
            ptab[1] = PrepEnt{p.ffn1_wu, (bf16_t*)(ws + WS_BT1), p.ffn1_norm, 1024, 2816, 2816, 128, 256, 128, 704, 0};
            ptab[2] = PrepEnt{p.ffn1_wd, (bf16_t*)(ws + WS_BT2), nullptr, 2816, 1024, 1024, BIG, 0, 0, 1408, 0};
            ptab[3] = PrepEnt{p.w_in, (bf16_t*)(ws + WS_BT3), p.mix_norm, 1024, NIN, NINP, BIG, 0, 0, 2112, 0};
            ptab[4] = PrepEnt{p.w_out, (bf16_t*)(ws + WS_BT4), nullptr, 1024, 1024, 1024, BIG, 0, 0, 2944, 0};
            ptab[5] = PrepEnt{p.ffn2_wg, (bf16_t*)(ws + WS_BT5), p.ffn2_norm, 1024, 2816, 2816, 128, 256, 0, 3200, 0};
            ptab[6] = PrepEnt{p.ffn2_wu, (bf16_t*)(ws + WS_BT5), p.ffn2_norm, 1024, 2816, 2816, 128, 256, 128, 3904, 0};
            ptab[7] = PrepEnt{p.ffn2_wd, (bf16_t*)(ws + WS_BT6), nullptr, 2816, 1024, 1024, BIG, 0, 0, 4608, 0};
        }
        __syncthreads();
        const float* src; bf16_t* dst; const float* scale; int K, N, blk, bs, boff, tk, tn; float v[8];
        PREP_DECODE(tix < 5312 ? tix : 0, src, dst, scale, K, N, blk, bs, boff, tk, tn);
        if (tix < 5312) prep_load(src, scale, N, tk, tn, t, v);
        while (tix < 5312) {
            const int nx = tix + gridDim.x;
            const float* src2 = src; bf16_t* dst2 = dst; const float* scale2 = scale; int K2 = K, N2 = N, blk2 = blk, bs2 = bs, boff2 = boff, tk2 = tk, tn2 = tn; float vn[8];
#pragma unroll
            for (int i = 0; i < 8; ++i) vn[i] = 0.f;
            if (nx < 5312) { PREP_DECODE(nx, src2, dst2, scale2, K2, N2, blk2, bs2, boff2, tk2, tn2); prep_load(src2, scale2, N2, tk2, tn2, t, vn); }
            prep_emit(dst, K, blk, bs, boff, tk, tn, t, v, tiles + par * (64 * 65));
            src = src2; dst = dst2; scale = scale2; K = K2; N = N2; blk = blk2; bs = bs2; boff = boff2; tk = tk2; tn = tn2;
#pragma unroll
            for (int i = 0; i < 8; ++i) v[i] = vn[i];
            tix = nx; par ^= 1;
        }
        __syncthreads();
    }
    { bf16_t* wc = (bf16_t*)(ws + WS_WC);
      for (int i = blockIdx.x * 512 + otid(); i < 8 * 128 * 128; i += gridDim.x * 512) { const int t = (i >> 7) & 127, s = i & 127; wc[i] = (t >= s) ? f2bf(p.sg_w[i]) : (bf16_t)0; } }
    { bf16_t* xb = (bf16_t*)(ws + WS_XB); float* ssq = (float*)(ws + WS_SSQ);
      const int tid = otid(), wid = tid >> 6, lane = tid & 63;
      int row = blockIdx.x * 8 + wid; f32x4 v[4];
#pragma unroll
      for (int i = 0; i < 4; ++i) v[i] = ((const f32x4*)(p.x + (size_t)row * DM))[lane + 64 * i];
      while (row < MTOK) {
          const int nrow = row + gridDim.x * 8; f32x4 vn[4];
#pragma unroll
          for (int i = 0; i < 4; ++i) vn[i] = v[i];
          if (nrow < MTOK) {
#pragma unroll
              for (int i = 0; i < 4; ++i) vn[i] = ((const f32x4*)(p.x + (size_t)nrow * DM))[lane + 64 * i];
          }
          float s = 0.f;
#pragma unroll
          for (int i = 0; i < 4; ++i) { s += v[i][0] * v[i][0] + v[i][1] * v[i][1] + v[i][2] * v[i][2] + v[i][3] * v[i][3];
              u32x2 w; w.x = pk(v[i][0], v[i][1]); w.y = pk(v[i][2], v[i][3]); *(u32x2*)(xb + (size_t)row * DM + (lane + 64 * i) * 4) = w; }
          s = wave_sum(s);
          if (lane == 0) { ssq[row] = s; ssq[row + (1 << 20)] = 0.f; ssq[row + (2 << 20)] = 0.f; ssq[row + (3 << 20)] = 0.f; }
#pragma unroll
          for (int i = 0; i < 4; ++i) v[i] = vn[i];
          row = nrow;
      } }
}
__device__ __forceinline__ void phase_final(const Params& p) {
    const float* ssq = (const float*)(p.ws + WS_SSQ + 3 * 4 * MiB); const bf16_t* xb = (const bf16_t*)(p.ws + WS_XB);
    const int tid = otid(), wid = tid >> 6, lane = tid & 63;
    f32x4 g[4];
#pragma unroll
    for (int i = 0; i < 4; ++i) g[i] = ((const f32x4*)p.final_norm)[2 * lane + 128 * (i >> 1) + (i & 1)];
    for (int row0 = (blockIdx.x * 8 + wid) * 4; row0 < MTOK; row0 += gridDim.x * 32) {
        u32x4 v[4][2]; float rs[4];
#pragma unroll
        for (int r = 0; r < 4; ++r) { const u32x4* xr = (const u32x4*)(xb + (size_t)(row0 + r) * DM); v[r][0] = xr[lane]; v[r][1] = xr[lane + 64]; rs[r] = ssq[row0 + r]; }
#pragma unroll
        for (int r = 0; r < 4; ++r) {
            const float rr = __builtin_amdgcn_rsqf(rs[r] * (1.0f / 1024.0f) + EPS);
            f32x4* o = (f32x4*)(p.out + (size_t)(row0 + r) * DM);
#pragma unroll
            for (int h = 0; h < 2; ++h) {
                const u32x4 q = v[r][h];
                const f32x4 a = (f32x4){bflo(q.x), bfhi(q.x), bflo(q.y), bfhi(q.y)} * rr * g[2 * h], b = (f32x4){bflo(q.z), bfhi(q.z), bflo(q.w), bfhi(q.w)} * rr * g[2 * h + 1];
                __builtin_nontemporal_store(a, &o[2 * (lane + 64 * h)]); __builtin_nontemporal_store(b, &o[2 * (lane + 64 * h) + 1]);
            }
        }
    }
}


__device__ __forceinline__ void phase_ba(const Params& p, unsigned char* shm) {
    unsigned char* ws = p.ws;
    const int tid = otid(), wid = tid >> 6, lane = tid & 63, fr = lane & 15, fq = lane >> 4;
    const bf16_t* XB = (const bf16_t*)(ws + WS_XB); const bf16_t* BT = (const bf16_t*)(ws + WS_BT3) + (size_t)12 * 16 * 16384  ; float* BA = (float*)(ws + WS_BA);
    const float* ssq = (const float*)(ws + WS_SSQ + 4 * MiB);
    constexpr int BST = 2064;
#pragma unroll
    for (int i = 0; i < 4; ++i) { const int c = tid + 512 * i, row = c >> 7, k0 = (c & 127) * 8;
        *(u32x4*)(shm + row * BST + k0 * 2) = *(const u32x4*)(BT + (size_t)(k0 >> 6) * 16384 + row * 64 + (k0 & 63)); }
    __syncthreads();
    for (int panel = blockIdx.x; panel < MTOK / 256; panel += gridDim.x) {
#pragma unroll
        for (int mt = 0; mt < 2; ++mt) {
            const int rbase = panel * 256 + wid * 32 + mt * 16;
            const bf16_t* ap = XB + (size_t)(rbase + fr) * DM + 8 * fq;
            bf16x8 af[32];
#pragma unroll
            for (int ks = 0; ks < 32; ++ks) af[ks] = *(const bf16x8*)(ap + 32 * ks);
            f32x4 acc = {0.f, 0.f, 0.f, 0.f};
#pragma unroll
            for (int ks = 0; ks < 32; ++ks) acc = MFMA16(af[ks], *(const bf16x8*)(shm + fr * BST + (32 * ks + 8 * fq) * 2), acc);
            if (fr < 8) {
                const int hh = fr & 3; const float al = p.a_log[hh], db = p.dt_bias[hh];
#pragma unroll
                for (int r = 0; r < 4; ++r) {
                    const int row = rbase + 4 * fq + r; const float v = acc[r] * rstd_of(ssq, row);
                    float o;
                    if (fr < 4) o = 1.0f / (1.0f + __expf(-v));
                    else { const float av = v + db; o = -__expf(al) * (fmaxf(av, 0.f) + log1pf(__expf(-fabsf(av)))); }
                    BA[(size_t)row * 8 + fr] = o;
                }
            }
        }
    }
    __syncthreads();
}
#define XB_TMO      128
#define XB_XCNT(j)  (256  + 64 * (j))
#define XB_XSUB(j)  (1280 + 64 * (j))
#define XB_XGEN(j)  (2304 + 64 * (j))
#define XB_TOP      3328
#define XB_TOPGEN   3392
#define XCD_BAR_WORDS 3456
#define XB_SPIN_CAP (1u << 18)

__device__ __forceinline__ unsigned xb_ld(unsigned* p)              { return __hip_atomic_load(p, __ATOMIC_RELAXED, __HIP_MEMORY_SCOPE_AGENT); }
__device__ __forceinline__ unsigned xb_add(unsigned* p, unsigned v) { return __hip_atomic_fetch_add(p, v, __ATOMIC_RELAXED, __HIP_MEMORY_SCOPE_AGENT); }
__device__ __forceinline__ unsigned xb_xcc_id() { return (unsigned)__builtin_amdgcn_s_getreg((3 << 11) | 20) & 0xFu; }
#define XB_SPIN(cond, bar) do { unsigned _sp = 0; while (cond) { __builtin_amdgcn_s_sleep(1); \
    if ((++_sp & 255u) == 0u) { if (xb_ld(&(bar)[XB_TMO])) break; if (_sp > XB_SPIN_CAP) { atomicAdd(&(bar)[XB_TMO], 1u); break; } } } } while (0)

struct XcdBarrier {
    unsigned* bar; unsigned x;
    volatile LAS unsigned* st;
};

__device__ __forceinline__ XcdBarrier xcd_barrier_post(unsigned* bar, volatile LAS unsigned* st) {
    XcdBarrier b; b.bar = bar; b.x = xb_xcc_id(); b.st = st;
    if (threadIdx.x == 0) (void)xb_add(&bar[XB_XCNT(b.x)], 1u);
    return b;
}
__device__ __forceinline__ void xcd_barrier_complete(unsigned* bar, unsigned x, unsigned& nloc, unsigned& nx) {
    const unsigned G = gridDim.x * gridDim.y * gridDim.z;
    unsigned sum, cnt, mine, sp = 0u;
    for (;;) {
        sum = 0u; cnt = 0u; mine = 0u;
#pragma unroll
        for (unsigned j = 0; j < 16; ++j) { const unsigned c = xb_ld(&bar[XB_XCNT(j)]); sum += c; cnt += (c > 0u) ? 1u : 0u; mine = (j == x) ? c : mine; }
        if (sum == G) break;
        __builtin_amdgcn_s_sleep(1);
        if ((++sp & 255u) == 0u) { if (xb_ld(&bar[XB_TMO])) break; if (sp > XB_SPIN_CAP) { atomicAdd(&bar[XB_TMO], 1u); break; } }
    }
    nloc = mine > 0u ? mine : 1u; nx = cnt > 0u ? cnt : 1u;
}

__device__ __forceinline__ void xcd_barrier(const XcdBarrier& b) {
    asm volatile("s_waitcnt vmcnt(0)" ::: "memory");
    __syncthreads();
    if (threadIdx.x == 0) {
        unsigned* bar = b.bar;
        __builtin_amdgcn_s_waitcnt(0);
        unsigned nloc = b.st[0], nx = b.st[1];
        if (nloc == 0u) { xcd_barrier_complete(bar, b.x, nloc, nx); b.st[0] = nloc; b.st[1] = nx; }
        const unsigned old = xb_add(&bar[XB_XSUB(b.x)], 1u);
        const unsigned gen = old / nloc;
        if (old + 1u == (gen + 1u) * nloc) {
            __builtin_amdgcn_fence(__ATOMIC_RELEASE, "agent");
            asm volatile("s_waitcnt vmcnt(0)" ::: "memory");
            const unsigned og = xb_add(&bar[XB_TOP], 1u);
            const unsigned tg = og / nx;
            if (og + 1u == (tg + 1u) * nx) xb_add(&bar[XB_TOPGEN], 1u);
            else XB_SPIN(xb_ld(&bar[XB_TOPGEN]) == tg, bar);
            __builtin_amdgcn_fence(__ATOMIC_ACQUIRE, "agent");
            xb_add(&bar[XB_XGEN(b.x)], 1u);
            asm volatile("s_waitcnt vmcnt(0)" ::: "memory");
        } else {
            XB_SPIN(xb_ld(&bar[XB_XGEN(b.x)]) == gen, bar);
            __builtin_amdgcn_fence(__ATOMIC_ACQUIRE, "agent");
            asm volatile("s_waitcnt vmcnt(0)" ::: "memory");
        }
    }
    __syncthreads();
}

constexpr int LDS_BAR_ST = 158 * 1024;
constexpr int LDS_BYTES = 158 * 1024 + 64;
constexpr int NPHASE = 10;
template <int PH> __device__ __forceinline__ void run_phase(const Params& p, unsigned char* shm) {
    unsigned char* ws = p.ws;
    pg8::StaticOrder S;
    float* ssq0 = (float*)(ws + WS_SSQ); float* ssq1 = (float*)(ws + WS_SSQ + 4 * MiB); float* ssq2 = (float*)(ws + WS_SSQ + 8 * MiB); float* ssq3 = (float*)(ws + WS_SSQ + 12 * MiB);
    if constexpr (PH == 0) { phase_prep(p, (float*)shm); }
    if constexpr (PH == 1) {
        Gemm g{(const bf16_t*)(ws + WS_XB), (const bf16_t*)(ws + WS_BT1), MTOK, 2 * DFF, DM}; S.init(g.M, g.N, (int)gridDim.x, (int)blockIdx.x);
        EpiGateUp E{(bf16_t*)(ws + WS_R1), ssq0};
        pg8::gemm_phase<EpiGateUp, pg8::StaticOrder, false>((PG8_LAS unsigned char*)shm, g, S, E, nullptr);
    }
    if constexpr (PH == 2) {
        Gemm g{(const bf16_t*)(ws + WS_R1), (const bf16_t*)(ws + WS_BT2), MTOK, DM, DFF}; S.init(g.M, g.N, (int)gridDim.x, (int)blockIdx.x);
        EpiResid<false> E{nullptr, (bf16_t*)(ws + WS_XB), ssq1, 0.5f};
        pg8::gemm_phase<EpiResid<false>, pg8::StaticOrder, false>((PG8_LAS unsigned char*)shm, g, S, E, nullptr);
    }
    if constexpr (PH == 3) {
        Gemm g{(const bf16_t*)(ws + WS_XB), (const bf16_t*)(ws + WS_BT3), MTOK, 3072, DM}; S.init(g.M, g.N, (int)gridDim.x, (int)blockIdx.x);
        EpiInProj E{ws, ssq1, p.a_log, p.dt_bias};
        pg8::gemm_phase<EpiInProj, pg8::StaticOrder, false>((PG8_LAS unsigned char*)shm, g, S, E, nullptr);
        phase_ba(p, shm);
    }
    if constexpr (PH == 4) { phase_dnpre(p, shm); }
    if constexpr (PH == 5) { phase_scan_sg(p, shm); }
    if constexpr (PH == 6) {
        Gemm g{(const bf16_t*)(ws + WS_MIX), (const bf16_t*)(ws + WS_BT4), MTOK, DM, DM}; S.init(g.M, g.N, (int)gridDim.x, (int)blockIdx.x);
        EpiResid<false> E{nullptr, (bf16_t*)(ws + WS_XB), ssq2, 1.0f};
        pg8::gemm_phase<EpiResid<false>, pg8::StaticOrder, false>((PG8_LAS unsigned char*)shm, g, S, E, nullptr);
    }
    if constexpr (PH == 7) {
        Gemm g{(const bf16_t*)(ws + WS_XB), (const bf16_t*)(ws + WS_BT5), MTOK, 2 * DFF, DM}; S.init(g.M, g.N, (int)gridDim.x, (int)blockIdx.x);
        EpiGateUp E{(bf16_t*)(ws + WS_R1), ssq2};
        pg8::gemm_phase<EpiGateUp, pg8::StaticOrder, false>((PG8_LAS unsigned char*)shm, g, S, E, nullptr);
    }
    if constexpr (PH == 8) {
        Gemm g{(const bf16_t*)(ws + WS_R1), (const bf16_t*)(ws + WS_BT6), MTOK, DM, DFF}; S.init(g.M, g.N, (int)gridDim.x, (int)blockIdx.x);
        EpiResid<false> E{nullptr, (bf16_t*)(ws + WS_XB), ssq3, 0.5f};
        pg8::gemm_phase<EpiResid<false>, pg8::StaticOrder, false>((PG8_LAS unsigned char*)shm, g, S, E, nullptr);
    }
    if constexpr (PH == 9) { phase_final(p); }
}
template <int PH> __global__ __launch_bounds__(512, 2) void k_phase(Params p) {
    extern __shared__ __attribute__((aligned(16))) unsigned char shm[];
    run_phase<PH>(p, shm);
}
__global__ __launch_bounds__(512, 2) void k_mega(Params p) {
    extern __shared__ __attribute__((aligned(16))) unsigned char shm[];
    cg::grid_group grid = cg::this_grid();
    volatile LAS unsigned* st = (volatile LAS unsigned*)(LAS unsigned char*)(shm + LDS_BAR_ST);
    if (threadIdx.x == 0) { st[0] = 0u; st[1] = 0u; }
    __syncthreads();
    const XcdBarrier xb = xcd_barrier_post((unsigned*)(p.ws + WS_BAR), st);
    if (p.out == nullptr) grid.sync();
    run_phase<0>(p, shm); xcd_barrier(xb);
    run_phase<1>(p, shm); xcd_barrier(xb);
    run_phase<2>(p, shm); xcd_barrier(xb);
    run_phase<3>(p, shm); xcd_barrier(xb);
    run_phase<4>(p, shm); xcd_barrier(xb);
    run_phase<5>(p, shm); xcd_barrier(xb);
    run_phase<6>(p, shm); xcd_barrier(xb);
    run_phase<7>(p, shm); xcd_barrier(xb);
    run_phase<8>(p, shm); xcd_barrier(xb);
    run_phase<9>(p, shm);
}

#ifndef MEGA
#define MEGA 1
#endif
template <int PH> static void launch_phase(const Params& p, hipStream_t stream) {
    static bool attr = false;
    if (!attr) { (void)hipFuncSetAttribute((const void*)k_phase<PH>, hipFuncAttributeMaxDynamicSharedMemorySize, LDS_BYTES); attr = true; }
    hipLaunchKernelGGL(k_phase<PH>, dim3(256), dim3(512), LDS_BYTES, stream, p);
}
extern "C" void kernel_launch(void* const* d_in, const int* in_sizes, int n_in, void* d_out, int out_size, void* d_ws, size_t ws_size, hipStream_t stream) {
    Params p{};
    const float** f = (const float**)&p;
    for (int i = 0; i < 21; ++i) f[i] = (const float*)d_in[i];
    p.out = (float*)d_out; p.ws = (unsigned char*)d_ws;
    if (ws_size < WS_END) { fprintf(stderr, "kernel_launch: workspace too small: %zu < %zu\n", ws_size, (size_t)WS_END); return; }
#if MEGA
    static int grid = 0;
    if (!grid) {
        (void)hipFuncSetAttribute((const void*)k_mega, hipFuncAttributeMaxDynamicSharedMemorySize, LDS_BYTES);
        int dev = 0, cus = 0, per_cu = 0; (void)hipGetDevice(&dev); (void)hipDeviceGetAttribute(&cus, hipDeviceAttributeMultiprocessorCount, dev);
        (void)hipOccupancyMaxActiveBlocksPerMultiprocessor(&per_cu, (const void*)k_mega, 512, LDS_BYTES);
        if (per_cu < 1) fprintf(stderr, "kernel_launch: occupancy query says %d blocks per CU\n", per_cu);
        grid = cus;
    }
    (void)hipMemsetAsync((unsigned char*)d_ws + WS_BAR, 0, XCD_BAR_WORDS * sizeof(unsigned), stream);
    void* args[] = {(void*)&p};
    hipError_t e = hipLaunchCooperativeKernel((const void*)k_mega, dim3(grid), dim3(512), args, LDS_BYTES, stream);
    if (e != hipSuccess) fprintf(stderr, "cooperative launch failed: %s (grid %d)\n", hipGetErrorString(e), grid);
#else
    launch_phase<0>(p, stream); launch_phase<1>(p, stream); launch_phase<2>(p, stream); launch_phase<3>(p, stream); launch_phase<4>(p, stream); launch_phase<5>(p, stream); launch_phase<6>(p, stream); launch_phase<7>(p, stream); launch_phase<8>(p, stream); launch_phase<9>(p, stream);
#endif
}
```
